# Optimizing an MI355X kernel written in HIP

```python
import math
import jax, jax.numpy as jnp
from jax import lax
import numpy as np

D_MODEL = 1024
BATCH = 4
SEQ = 8192
DEPTH = 4

D_FF = 2816
PLE_DIM = 256
CONV_WIDTH = 3
CONV_CH = 512
S5_CH = 512
S5_GROUP = 16
S5_GROUPS = S5_CH // S5_GROUP
S5_STATE = 64
AB_IN = 3 * CONV_CH + S5_CH
N_HEADS = 8
HEAD_DIM = 128
N_KV_HEADS = 2
IDX_HEADS = 8
IDX_DIM = 64
TOPK_MAX = 256
Q_BLOCK = 128
C_SIZES = (N_HEADS * HEAD_DIM, N_KV_HEADS * HEAD_DIM, N_KV_HEADS * HEAD_DIM,
           IDX_HEADS * IDX_DIM, IDX_DIM, IDX_HEADS)
C_SPLITS = tuple(int(v) for v in np.cumsum(C_SIZES)[:-1])
C_IN = int(sum(C_SIZES))
ROPE_THETA = 500000.0
ROT_FRAC = 4
LN_EPS = 1e-5
DN_ALPHA = (2 * DEPTH) ** 0.25
DN_BETA = (8 * DEPTH) ** -0.25
N_EVEN = (DEPTH + 1) // 2
N_ODD = DEPTH // 2

kernel_name = 'hybrid_conv_s5_dsa_macaron_deepnorm'


def layer_norm(x, g, b):
    xf = x.astype(jnp.float32)
    mu = jnp.mean(xf, axis=-1, keepdims=True)
    var = jnp.mean(jnp.square(xf - mu), axis=-1, keepdims=True)
    return ((xf - mu) * lax.rsqrt(var + LN_EPS) * g.astype(jnp.float32) + b.astype(jnp.float32)).astype(x.dtype)


def swiglu(x, w1, w3, w2):
    return (jax.nn.silu(x @ w1) * (x @ w3)) @ w2


def rope_tables(positions, rot_dim):
    inv = ROPE_THETA ** (-jnp.arange(0, rot_dim, 2, dtype=jnp.float32) / rot_dim)
    ang = positions.astype(jnp.float32)[..., None] * inv
    return jnp.cos(ang), jnp.sin(ang)


def partial_rope(t, cos, sin):
    half = cos.shape[-1]
    r = 2 * half
    tr = t[..., :r].astype(jnp.float32)
    t1, t2 = tr[..., :half], tr[..., half:]
    rot = jnp.concatenate([t1 * cos - t2 * sin, t2 * cos + t1 * sin], axis=-1).astype(t.dtype)
    return jnp.concatenate([rot, t[..., r:]], axis=-1)


def short_conv_mixer(h, gb, gc, conv_w):
    u = gc * h
    L = u.shape[1]
    up = jnp.pad(u, ((0, 0), (CONV_WIDTH - 1, 0), (0, 0)))
    v = sum(conv_w[j] * up[:, j:j + L] for j in range(CONV_WIDTH))
    return gb * v


def s5_mixer(u, lam_re, lam_im, log_dt, b_re, b_im, c_re, c_im, d_skip, w_glu, b_glu):
    f32 = jnp.float32
    Bt, L, _ = u.shape
    uf = u.astype(f32)
    ug = uf.reshape(Bt, L, S5_GROUPS, S5_GROUP)
    lr = jnp.minimum(lam_re.astype(f32), -1e-4)
    li = lam_im.astype(f32)
    dt = jnp.exp(log_dt.astype(f32))[:, None]
    mag = jnp.exp(lr * dt)
    ab_re = mag * jnp.cos(li * dt)
    ab_im = mag * jnp.sin(li * dt)
    nr, ni = ab_re - 1.0, ab_im
    den = lr * lr + li * li
    f_re = (nr * lr + ni * li) / den
    f_im = (ni * lr - nr * li) / den
    br, bi = b_re.astype(f32), b_im.astype(f32)
    bb_re = f_re[..., None] * br - f_im[..., None] * bi
    bb_im = f_re[..., None] * bi + f_im[..., None] * br
    bu_re = jnp.einsum('blgc,gpc->blgp', ug, bb_re)
    bu_im = jnp.einsum('blgc,gpc->blgp', ug, bb_im)
    a_re = jnp.broadcast_to(ab_re, bu_re.shape)
    a_im = jnp.broadcast_to(ab_im, bu_im.shape)

    def combine(e1, e2):
        a1r, a1i, b1r, b1i = e1
        a2r, a2i, b2r, b2i = e2
        return (a2r * a1r - a2i * a1i, a2r * a1i + a2i * a1r,
                a2r * b1r - a2i * b1i + b2r, a2r * b1i + a2i * b1r + b2i)

    _, _, s_re, s_im = lax.associative_scan(combine, (a_re, a_im, bu_re, bu_im), axis=1)
    y = (jnp.einsum('blgp,gcp->blgc', s_re, c_re.astype(f32))
         - jnp.einsum('blgp,gcp->blgc', s_im, c_im.astype(f32)))
    y = y.reshape(Bt, L, S5_CH) + d_skip.astype(f32) * uf
    z = jax.nn.gelu(y)
    out = z * jax.nn.sigmoid(z @ w_glu.astype(f32) + b_glu.astype(f32))
    return out.astype(u.dtype)


def dsa_mixer(proj, cos_a, sin_a, cos_i, sin_i):
    f32 = jnp.float32
    Bt, L, _ = proj.shape
    q, k, v, qi, ki, wi = jnp.split(proj, C_SPLITS, axis=-1)
    q = partial_rope(q.reshape(Bt, L, N_HEADS, HEAD_DIM), cos_a[:, :, None], sin_a[:, :, None])
    k = partial_rope(k.reshape(Bt, L, N_KV_HEADS, HEAD_DIM), cos_a[:, :, None], sin_a[:, :, None])
    v = v.reshape(Bt, L, N_KV_HEADS, HEAD_DIM)
    qi = partial_rope(qi.reshape(Bt, L, IDX_HEADS, IDX_DIM), cos_i[:, :, None], sin_i[:, :, None])
    ki = partial_rope(ki, cos_i, sin_i).astype(f32)
    wi = wi.astype(f32) * (IDX_HEADS ** -0.5 * IDX_DIM ** -0.5)
    topk = min(TOPK_MAX, L // 4)
    nb = L // Q_BLOCK

    def to_blocks(t):
        return jnp.moveaxis(t.reshape(Bt, nb, Q_BLOCK, *t.shape[2:]), 1, 0)

    t_pos = jnp.arange(L, dtype=jnp.int32).reshape(nb, Q_BLOCK)
    key_pos = jnp.arange(L, dtype=jnp.int32)
    bidx = jnp.arange(Bt)[:, None, None]
    rep = N_HEADS // N_KV_HEADS

    def block(args):
        qb, qib, wb, tb = args
        logits = jax.nn.relu(jnp.einsum('bthd,bsd->bths', qib.astype(f32), ki))
        score = jnp.einsum('bths,bth->bts', logits, wb)
        causal = key_pos[None, :] <= tb[:, None]
        score = jnp.where(causal[None], score, -jnp.inf)
        _, idx = lax.top_k(score, topk)
        valid = idx <= tb[None, :, None]
        k_sel = k[bidx, idx]
        v_sel = v[bidx, idx]
        qg = qb.reshape(Bt, Q_BLOCK, N_KV_HEADS, rep, HEAD_DIM)
        s = jnp.einsum('btgrd,btjgd->btgrj', qg, k_sel).astype(f32) * (HEAD_DIM ** -0.5)
        s = jnp.where(valid[:, :, None, None, :], s, -jnp.inf)
        pr = jax.nn.softmax(s, axis=-1)
        o = jnp.einsum('btgrj,btjgd->btgrd', pr.astype(v.dtype), v_sel)
        return o.reshape(Bt, Q_BLOCK, N_HEADS * HEAD_DIM)

    out = lax.map(block, (to_blocks(q), to_blocks(qi), to_blocks(wi), t_pos))
    return jnp.moveaxis(out, 0, 1).reshape(Bt, L, N_HEADS * HEAD_DIM)


def setup_inputs(seed: int = 0) -> dict:
    key = jax.random.key(seed)
    ks = jax.random.split(key, 32)
    f32 = jnp.float32

    def nrm(i, shape, scale):
        return jax.random.normal(ks[i], shape, f32) * scale

    x = nrm(0, (BATCH, SEQ, D_MODEL), 1.0)
    p = nrm(1, (DEPTH, BATCH, SEQ, PLE_DIM), 1.0)
    offs = jax.random.randint(ks[2], (BATCH, 1), 0, 1024, dtype=jnp.int32)
    positions = offs + jnp.arange(SEQ, dtype=jnp.int32)[None, :]
    ln_g = 1.0 + nrm(3, (DEPTH, 3, D_MODEL), 0.02)
    ln_b = nrm(4, (DEPTH, 3, D_MODEL), 0.02)
    ffn_w1 = nrm(5, (DEPTH, 2, D_MODEL, D_FF), D_MODEL ** -0.5)
    ffn_w3 = nrm(6, (DEPTH, 2, D_MODEL, D_FF), D_MODEL ** -0.5)
    ffn_w2 = nrm(7, (DEPTH, 2, D_FF, D_MODEL), D_FF ** -0.5 * DN_BETA)
    ple_w_proj = nrm(8, (DEPTH, PLE_DIM, D_MODEL), PLE_DIM ** -0.5)
    ple_w_gate = nrm(9, (DEPTH, D_MODEL, D_MODEL), D_MODEL ** -0.5)
    ab_w_in = nrm(10, (N_EVEN, D_MODEL, AB_IN), D_MODEL ** -0.5)
    ab_w_out = nrm(11, (N_EVEN, CONV_CH + S5_CH, D_MODEL), (CONV_CH + S5_CH) ** -0.5 * DN_BETA)
    conv_w = nrm(12, (N_EVEN, CONV_WIDTH, CONV_CH), CONV_WIDTH ** -0.5)
    s5_lam_re = -0.5 + nrm(13, (N_EVEN, S5_GROUPS, S5_STATE), 0.01)
    s5_lam_im = (math.pi * jnp.arange(S5_STATE, dtype=f32))[None, None, :] + nrm(14, (N_EVEN, S5_GROUPS, S5_STATE), 0.01)
    s5_log_dt = jax.random.uniform(ks[15], (N_EVEN, S5_GROUPS), f32, math.log(1e-3), math.log(1e-1))
    s5_b_re = nrm(16, (N_EVEN, S5_GROUPS, S5_STATE, S5_GROUP), (2 * S5_GROUP) ** -0.5)
    s5_b_im = nrm(17, (N_EVEN, S5_GROUPS, S5_STATE, S5_GROUP), (2 * S5_GROUP) ** -0.5)
    s5_c_re = nrm(18, (N_EVEN, S5_GROUPS, S5_GROUP, S5_STATE), S5_STATE ** -0.5)
    s5_c_im = nrm(19, (N_EVEN, S5_GROUPS, S5_GROUP, S5_STATE), S5_STATE ** -0.5)
    s5_d = nrm(20, (N_EVEN, S5_CH), 1.0)
    s5_w_glu = nrm(21, (N_EVEN, S5_CH, S5_CH), S5_CH ** -0.5)
    s5_b_glu = nrm(22, (N_EVEN, S5_CH), 0.02)
    c_w_in = nrm(23, (N_ODD, D_MODEL, C_IN), D_MODEL ** -0.5)
    c_w_out = nrm(24, (N_ODD, N_HEADS * HEAD_DIM, D_MODEL), (N_HEADS * HEAD_DIM) ** -0.5 * DN_BETA)
    return {'x': x, 'p': p, 'positions': positions, 'ln_g': ln_g, 'ln_b': ln_b,
            'ffn_w1': ffn_w1, 'ffn_w3': ffn_w3, 'ffn_w2': ffn_w2,
            'ple_w_proj': ple_w_proj, 'ple_w_gate': ple_w_gate,
            'ab_w_in': ab_w_in, 'ab_w_out': ab_w_out, 'conv_w': conv_w,
            's5_lam_re': s5_lam_re, 's5_lam_im': s5_lam_im, 's5_log_dt': s5_log_dt,
            's5_b_re': s5_b_re, 's5_b_im': s5_b_im, 's5_c_re': s5_c_re, 's5_c_im': s5_c_im,
            's5_d': s5_d, 's5_w_glu': s5_w_glu, 's5_b_glu': s5_b_glu,
            'c_w_in': c_w_in, 'c_w_out': c_w_out}


def reference(x, p, positions, ln_g, ln_b, ffn_w1, ffn_w3, ffn_w2, ple_w_proj, ple_w_gate,
              ab_w_in, ab_w_out, conv_w, s5_lam_re, s5_lam_im, s5_log_dt, s5_b_re, s5_b_im,
              s5_c_re, s5_c_im, s5_d, s5_w_glu, s5_b_glu, c_w_in, c_w_out):
    cos_a, sin_a = rope_tables(positions, HEAD_DIM // ROT_FRAC)
    cos_i, sin_i = rope_tables(positions, IDX_DIM // ROT_FRAC)
    h = x
    for i in range(DEPTH):
        h = layer_norm(DN_ALPHA * h + 0.5 * swiglu(h, ffn_w1[i, 0], ffn_w3[i, 0], ffn_w2[i, 0]),
                       ln_g[i, 0], ln_b[i, 0])
        j = i // 2
        if i % 2 == 0:
            proj = h @ ab_w_in[j]
            hc, gb, gc, u = jnp.split(proj, [CONV_CH, 2 * CONV_CH, 3 * CONV_CH], axis=-1)
            ya = short_conv_mixer(hc, gb, gc, conv_w[j])
            yb = s5_mixer(u, s5_lam_re[j], s5_lam_im[j], s5_log_dt[j], s5_b_re[j], s5_b_im[j],
                          s5_c_re[j], s5_c_im[j], s5_d[j], s5_w_glu[j], s5_b_glu[j])
            mix = jnp.concatenate([ya, yb], axis=-1) @ ab_w_out[j]
        else:
            proj = h @ c_w_in[j]
            mix = dsa_mixer(proj, cos_a, sin_a, cos_i, sin_i) @ c_w_out[j]
        h = layer_norm(DN_ALPHA * h + mix, ln_g[i, 1], ln_b[i, 1])
        h = layer_norm(DN_ALPHA * h + 0.5 * swiglu(h, ffn_w1[i, 1], ffn_w3[i, 1], ffn_w2[i, 1]),
                       ln_g[i, 2], ln_b[i, 2])
        h = h + (p[i] @ ple_w_proj[i]) * jax.nn.sigmoid(h @ ple_w_gate[i])
    return h
```

```cpp
#include <hip/hip_runtime.h>
#include <hip/hip_cooperative_groups.h>
#include <cstdio>
namespace cg = cooperative_groups;

#define LAS __attribute__((address_space(3)))
typedef _Float16 h16;
typedef _Float16 h16x8 __attribute__((ext_vector_type(8)));
typedef _Float16 h16x4 __attribute__((ext_vector_type(4)));
typedef _Float16 h16x2 __attribute__((ext_vector_type(2)));
typedef float f32x4 __attribute__((ext_vector_type(4)));
typedef float f32x2 __attribute__((ext_vector_type(2)));

constexpr int NTOK = 32768, DM = 1024, DFF = 2816, SEQ = 8192, NBATCH = 4, DEPTH = 4;
constexpr float DN_ALPHA = 1.6817928305074292f;
constexpr float LN_EPS = 1e-5f;
constexpr int LDS_BYTES = 147456;

constexpr size_t SZ_W13 = (size_t)5632 * 1024 * 2, SZ_W2T = (size_t)1024 * 2816 * 2, SZ_WPT = (size_t)1024 * 256 * 2, SZ_SQ = (size_t)1024 * 1024 * 2;
constexpr size_t SZ_ABIN = (size_t)2048 * 1024 * 2, SZ_WGLU = (size_t)512 * 512 * 2, SZ_CIN = (size_t)2304 * 1024 * 2;
constexpr size_t SZ_W1M = (size_t)32 * 256 * 512 * 2, SZ_M2 = (size_t)32 * 512 * 640 * 2;
constexpr size_t OFF_W13 = 0;
constexpr size_t OFF_W2T = OFF_W13 + 8 * SZ_W13;
constexpr size_t OFF_WPT = OFF_W2T + 8 * SZ_W2T;
constexpr size_t OFF_WGT = OFF_WPT + 4 * SZ_WPT;
constexpr size_t OFF_ABIN = OFF_WGT + 4 * SZ_SQ;
constexpr size_t OFF_ABOUT = OFF_ABIN + 2 * SZ_ABIN;
constexpr size_t OFF_WGLU = OFF_ABOUT + 2 * SZ_SQ;
constexpr size_t OFF_CIN = OFF_WGLU + 2 * SZ_WGLU;
constexpr size_t OFF_COUT = OFF_CIN + 2 * SZ_CIN;
constexpr size_t OFF_W1M = OFF_COUT + 2 * SZ_SQ;
constexpr size_t OFF_M2 = OFF_W1M + 2 * SZ_W1M;
constexpr size_t OFF_A32 = OFF_M2 + 2 * SZ_M2;
constexpr size_t OFF_H16 = OFF_A32 + 65536;
constexpr size_t OFF_R1 = OFF_H16 + (size_t)NTOK * DM * 2;
constexpr size_t SZ_R1 = (size_t)201326592;
constexpr size_t OFF_MIXA = OFF_R1 + SZ_R1;
constexpr size_t OFF_P16 = OFF_MIXA + (size_t)NTOK * DM * 2;
constexpr size_t OFF_BAR = OFF_P16 + (size_t)NTOK * 256 * 2;
constexpr size_t WS_END = OFF_BAR + 16384;
constexpr size_t R1_UG = (size_t)NTOK * 1536 * 2;
constexpr size_t R1_SLOC = R1_UG + (size_t)32 * 1024 * 640 * 2;
constexpr size_t R1_Z = R1_SLOC + (size_t)32 * 1024 * 128 * 4;
static_assert(R1_Z + (size_t)NTOK * 512 * 2 <= SZ_R1, "R1 layout");
constexpr size_t O_Q = 0, O_KG = (size_t)NTOK * 1024, O_VG = O_KG + (size_t)NTOK * 256, O_QI = O_VG + (size_t)NTOK * 256, O_KI = O_QI + (size_t)NTOK * 512, O_WI = O_KI + (size_t)NTOK * 64;
constexpr size_t R1_IDX = (O_WI + (size_t)NTOK * 8) * 2;
constexpr size_t R1_CNT = R1_IDX + (size_t)NTOK * 256 * 2;
static_assert(R1_CNT + (size_t)NTOK * 4 <= SZ_R1, "R1 layout (odd)");

struct Params {
    const float* x; const float* p; const int* pos;
    const float *ln_g, *ln_b, *w1, *w3, *w2, *plep, *pleg, *abin, *about, *convw, *lamre, *lamim, *logdt, *bre, *bim, *cre, *cim, *s5d, *wglu, *bglu, *cin, *cout;
    float* out; unsigned char* ws;
};

__device__ __forceinline__ float sigmoidf_(float x) { return __builtin_amdgcn_rcpf(1.f + __expf(-x)); }
__device__ __forceinline__ float gelu_tanh(float x) { const float u = 0.7978845608028654f * (x + 0.044715f * x * x * x); return 0.5f * x * (2.f - 2.f * __builtin_amdgcn_rcpf(1.f + __expf(2.f * u))); }
__device__ __forceinline__ h16x4 cvt4(f32x4 v) { h16x4 r; r.x = (h16)v.x; r.y = (h16)v.y; r.z = (h16)v.z; r.w = (h16)v.w; return r; }
__device__ __forceinline__ float wave_sum(float v) {
#pragma unroll
    for (int o = 1; o < 64; o <<= 1) v += __shfl_xor(v, o);
    return v;
}
__device__ __forceinline__ void rope_sc(float pos, float inv, float& c, float& s) {
    const float ang = pos * inv;
    const double a = (double)ang;
    const double n = __builtin_rint(a * 0.15915494309189535);
    const float r = (float)(a - n * 6.283185307179586);
    s = __sinf(r); c = __cosf(r);
}

constexpr int BM = 256, BK = 64, HALF = 128, HTB = HALF * BK * 2, NXCD = 8, WGM = 8;
__device__ __forceinline__ int lds_byte(int r, int c) { const int st = (r >> 4) * 2 + (c >> 5), rr = r & 15, cc = c & 31, ob = rr * 64 + cc * 2; return st * 1024 + (ob ^ (((ob >> 9) & 1) << 5)); }
__device__ __forceinline__ void stage_rc(int b, int& R, int& C) { const int st = b / 1024, sb = b % 1024, swz = sb ^ (((sb >> 9) & 1) << 5); R = (st >> 1) * 16 + swz / 64; C = (st & 1) * 32 + (swz % 64) / 2; }

struct Unit { int pb, pm, pn; };
struct Gemm { const h16* A; const h16* Bt; int lda, ldb, nM, nN, nB, K; size_t strideA, strideB; };
struct EpiArgs { float* f0; const float* cf0; h16* h0; h16* h1; const h16* ch0; const h16* ch1; const int* pos; float s0; };

__device__ __forceinline__ bool unit_next(const Gemm& g, int i, Unit& u) {
    const int nwg = g.nM * g.nN; const long L = (long)i * gridDim.x + blockIdx.x; if (L >= (long)nwg * g.nB) return false;
    u.pb = (int)(L / nwg); int wgid = (int)(L % nwg);
    { const int q = nwg / NXCD, r = nwg % NXCD, xcd = wgid % NXCD, off = wgid / NXCD; wgid = (xcd < r ? xcd * (q + 1) : r * (q + 1) + (xcd - r) * q) + off; }
    const int nig = WGM * g.nN, gid = wgid / nig, fm = gid * WGM, gsz = (g.nM - fm) < WGM ? (g.nM - fm) : WGM;
    u.pm = fm + ((wgid % nig) % gsz); u.pn = (wgid % nig) / gsz; return true;
}

enum { E_SWIGLU = 0, E_RES = 1, E_PROJ_EVEN = 2, E_S5A = 3, E_S5B = 4, E_GLU = 5, E_PROJ_ODD = 6, E_PP = 7, E_PLE = 8 };

template <int MODE>
__device__ __forceinline__ void epilogue(const f32x4 (&acc)[2][2][4][2], const Unit& u, const EpiArgs& E, int wr, int wc, int fr, int fq) {
    const int row0 = u.pm * BM + wr * 64 + fr, tc0 = wc * 32 + 4 * fq;
    h16* obase = nullptr; int orstride = 0, obstride = 0;
    if constexpr (MODE == E_PROJ_ODD) {
        if (u.pn < 4) { obase = E.h0 + O_Q + u.pn * 256; orstride = 1024; obstride = 128; }
        else if (u.pn < 6) { obase = E.h0 + (u.pn == 4 ? O_KG : O_VG) + (size_t)((u.pm * BM) >> 13) * SEQ * 128; orstride = 128; obstride = SEQ * 128; }
        else if (u.pn < 8) { obase = E.h0 + O_QI + (u.pn - 6) * 256; orstride = 512; obstride = 128; }
        else { obase = E.h0 + O_KI; orstride = 64; obstride = 0; }
    }
#pragma unroll
    for (int ai = 0; ai < 2; ++ai)
#pragma unroll
        for (int m = 0; m < 4; ++m) {
            int row = row0 + ai * HALF + m * 16; asm volatile("" : "+v"(row));
            if constexpr (MODE == E_SWIGLU) {
                h16x8 o8;
#pragma unroll
                for (int bj = 0; bj < 2; ++bj) {
                    const f32x4 a = acc[ai][bj][m][0], b = acc[ai][bj][m][1];
#pragma unroll
                    for (int j = 0; j < 4; ++j) o8[4 * bj + j] = (h16)(a[j] * sigmoidf_(a[j]) * b[j]);
                }
                *(h16x8*)(E.h0 + (size_t)row * DFF + u.pn * 128 + wc * 32 + 8 * fq) = o8;
            } else if constexpr (MODE == E_PROJ_ODD) {
                const float pos = (float)E.pos[row];
                float cs[4], sn[4];
                const bool rot_a = (u.pn <= 4) && (wc == 0);
                const bool rot_i = (u.pn >= 6) && ((u.pn < 8) ? ((wc & 1) == 0) : (wc == 0));
                if (rot_a) {
#pragma unroll
                    for (int j = 0; j < 4; ++j) rope_sc(pos, exp2f(-(float)(4 * fq + j) * (18.931568569324174f / 16.f)), cs[j], sn[j]);
                } else if (rot_i) {
#pragma unroll
                    for (int j = 0; j < 4; ++j) rope_sc(pos, exp2f(-(float)((4 * fq + j) & 7) * (18.931568569324174f / 8.f)), cs[j], sn[j]);
                }
#pragma unroll
                for (int bj = 0; bj < 2; ++bj) {
                    f32x4 v0 = acc[ai][bj][m][0], v1 = acc[ai][bj][m][1];
                    if (rot_a) {
                        f32x4 t0, t1;
#pragma unroll
                        for (int j = 0; j < 4; ++j) { t0[j] = v0[j] * cs[j] - v1[j] * sn[j]; t1[j] = v1[j] * cs[j] + v0[j] * sn[j]; }
                        v0 = t0; v1 = t1;
                    }
                    if (u.pn >= 6) {
                        f32x4 y;
#pragma unroll
                        for (int j = 0; j < 4; ++j) y[j] = __shfl_xor(v0[j], 32);
                        if (rot_i && (u.pn < 8 || bj == 0)) {
#pragma unroll
                            for (int j = 0; j < 4; ++j) v0[j] = (fq < 2) ? (v0[j] * cs[j] - y[j] * sn[j]) : (v0[j] * cs[j] + y[j] * sn[j]);
                        }
                    }
                    if (u.pn == 4 || u.pn == 5) {
                        unsigned char* o8 = (unsigned char*)(E.h0 + (u.pn == 4 ? O_KG : O_VG)) + ((size_t)((row >> 13) * 2 + bj) * SEQ + (row & (SEQ - 1))) * 128 + tc0;
                        int w0 = __builtin_amdgcn_cvt_pk_fp8_f32(v0[0], v0[1], 0, false); w0 = __builtin_amdgcn_cvt_pk_fp8_f32(v0[2], v0[3], w0, true);
                        int w1 = __builtin_amdgcn_cvt_pk_fp8_f32(v1[0], v1[1], 0, false); w1 = __builtin_amdgcn_cvt_pk_fp8_f32(v1[2], v1[3], w1, true);
                        *(int*)o8 = w0; *(int*)(o8 + 16) = w1;
                    } else if (u.pn < 8 || (bj == 0 && wc < 2)) { h16* o = obase + (size_t)row * orstride + bj * obstride + tc0; *(h16x4*)o = cvt4(v0); *(h16x4*)(o + 16) = cvt4(v1); }
                    else if (bj == 0 && wc == 2 && fq < 2) *(h16x4*)(E.h0 + O_WI + (size_t)row * 8 + 4 * fq) = cvt4(v0);
                }
            } else if constexpr (MODE == E_RES || MODE == E_PLE || MODE == E_PP || MODE == E_GLU) {
#pragma unroll
                for (int bj = 0; bj < 2; ++bj) {
                    const int col = u.pn * 256 + bj * 128 + wc * 32 + 8 * fq;
                    const f32x4 v0 = acc[ai][bj][m][0], v1 = acc[ai][bj][m][1];
                    float vv[8] = {v0[0], v0[1], v0[2], v0[3], v1[0], v1[1], v1[2], v1[3]};
                    h16x8 o;
                    if constexpr (MODE == E_RES) {
                        const h16x8 hh = *(const h16x8*)(E.ch0 + (size_t)row * DM + col);
#pragma unroll
                        for (int j = 0; j < 8; ++j) o[j] = (h16)((float)hh[j] * DN_ALPHA + vv[j] * E.s0);
                        *(h16x8*)(E.h0 + (size_t)row * DM + col) = o;
                    } else if constexpr (MODE == E_GLU) {
                        const h16x8 zz = *(const h16x8*)(E.ch0 + (size_t)row * 512 + col); const f32x4 b0 = *(const f32x4*)(E.cf0 + col), b1 = *(const f32x4*)(E.cf0 + col + 4);
                        const float bb[8] = {b0[0], b0[1], b0[2], b0[3], b1[0], b1[1], b1[2], b1[3]};
#pragma unroll
                        for (int j = 0; j < 8; ++j) o[j] = (h16)((float)zz[j] * sigmoidf_(vv[j] + bb[j]));
                        *(h16x8*)(E.h0 + (size_t)row * DM + 512 + col) = o;
                    } else if constexpr (MODE == E_PP) {
#pragma unroll
                        for (int j = 0; j < 8; ++j) o[j] = (h16)vv[j];
                        *(h16x8*)(E.h0 + (size_t)row * DM + col) = o;
                    } else {
                        const h16x8 hh = *(const h16x8*)(E.ch1 + (size_t)row * DM + col); const h16x8 pp = *(const h16x8*)(E.ch0 + (size_t)row * DM + col); float of[8];
#pragma unroll
                        for (int j = 0; j < 8; ++j) { of[j] = (float)hh[j] + (float)pp[j] * sigmoidf_(vv[j]); o[j] = (h16)of[j]; }
                        if (E.f0) { *(f32x4*)(E.f0 + (size_t)row * DM + col) = (f32x4){of[0], of[1], of[2], of[3]}; *(f32x4*)(E.f0 + (size_t)row * DM + col + 4) = (f32x4){of[4], of[5], of[6], of[7]}; }
                        *(h16x8*)(E.h0 + (size_t)row * DM + col) = o;
                    }
                }
            } else {
#pragma unroll
                for (int bj = 0; bj < 2; ++bj)
#pragma unroll
                    for (int n = 0; n < 2; ++n) {
                        const int tc = bj * 128 + tc0 + n * 16, col = u.pn * 256 + tc;
                        const f32x4 v = acc[ai][bj][m][n];
                        if constexpr (MODE == E_RES) {
                            const h16x4 hh = *(const h16x4*)(E.ch0 + (size_t)row * DM + col); f32x4 y;
#pragma unroll
                            for (int j = 0; j < 4; ++j) y[j] = (float)hh[j] * DN_ALPHA + v[j] * E.s0;
                            *(h16x4*)(E.h0 + (size_t)row * DM + col) = cvt4(y);
                        } else if constexpr (MODE == E_PROJ_EVEN) {
                            if (u.pn < 6) *(h16x4*)(E.h0 + (size_t)row * 1536 + col) = cvt4(v);
                            else { const int ch = col - 1536, g = ch >> 4, ci = ch & 15;
                                *(h16x4*)(E.h1 + ((size_t)g * 1024 + (row >> 5)) * 640 + (row & 31) * 16 + ci) = cvt4(v); }
                        } else if constexpr (MODE == E_S5A) {
                            if (bj == 0) *(f32x4*)(E.f0 + ((size_t)u.pb * 1024 + row) * 128 + tc) = v * (1.f / 1024.f);
                        } else if constexpr (MODE == E_S5B) {
                            const int t = col >> 4, co = col & 15, ch = u.pb * 16 + co;
                            const h16x4 uu = *(const h16x4*)(E.ch0 + ((size_t)u.pb * 1024 + row) * 640 + col);
                            const f32x4 d = *(const f32x4*)(E.cf0 + ch); f32x4 z;
#pragma unroll
                            for (int j = 0; j < 4; ++j) z[j] = gelu_tanh(v[j] * (1.f / 1024.f) + d[j] * (float)uu[j]);
                            *(h16x4*)(E.h0 + ((size_t)row * 32 + t) * 512 + ch) = cvt4(z);
                        } else if constexpr (MODE == E_GLU) {
                            const h16x4 zz = *(const h16x4*)(E.ch0 + (size_t)row * 512 + col); const f32x4 bb = *(const f32x4*)(E.cf0 + col); f32x4 o;
#pragma unroll
                            for (int j = 0; j < 4; ++j) o[j] = (float)zz[j] * sigmoidf_(v[j] + bb[j]);
                            *(h16x4*)(E.h0 + (size_t)row * DM + 512 + col) = cvt4(o);
                        } else if constexpr (MODE == E_PP) {
                            *(h16x4*)(E.h0 + (size_t)row * DM + col) = cvt4(v);
                        } else if constexpr (MODE == E_PLE) {
                            const h16x4 hh = *(const h16x4*)(E.ch1 + (size_t)row * DM + col); const h16x4 pp = *(const h16x4*)(E.ch0 + (size_t)row * DM + col); f32x4 o;
#pragma unroll
                            for (int j = 0; j < 4; ++j) o[j] = (float)hh[j] + (float)pp[j] * sigmoidf_(v[j]);
                            if (E.f0) *(f32x4*)(E.f0 + (size_t)row * DM + col) = o;
                            *(h16x4*)(E.h0 + (size_t)row * DM + col) = cvt4(o);
                        }
                    }
            }
            __builtin_amdgcn_sched_barrier(0);
        }
}

template <int MODE>
__device__ __forceinline__ void gemm_phase(LAS unsigned char* lds, const Gemm g, const EpiArgs E) {
    int tid_ = threadIdx.x; asm volatile("" : "+v"(tid_));
    const int tid = tid_, wid = __builtin_amdgcn_readfirstlane(tid >> 6), lane = tid & 63, wr = wid >> 2, wc = wid & 3, fr = lane & 15, fq = lane >> 4;
    const int K = g.K, nt = K / BK;
    unsigned voffA[2], voffB[2];
    constexpr bool PERM = (MODE == E_RES || MODE == E_PLE || MODE == E_PP || MODE == E_GLU);
#pragma unroll
    for (int i = 0; i < 2; ++i) { int R, C; stage_rc(tid * 16 + i * 8192, R, C);
        int Rb = R; if (PERM) { const int rho = R & 31, nn = rho >> 4, ii = rho & 15; Rb = (R & ~31) + 8 * (ii >> 2) + 4 * nn + (ii & 3); }
        voffA[i] = (unsigned)(R * g.lda + C) * 2u; voffB[i] = (unsigned)(Rb * g.ldb + C) * 2u; }
    const size_t kstep = (size_t)(BK * 2);
    const size_t hstepA = (size_t)HALF * g.lda * 2, hstepB = (size_t)HALF * g.ldb * 2;
    const unsigned ldsw = (unsigned)wid * 1024u;
    const int aoff = lds_byte(wr * 64 + fr, fq * 8), boff = lds_byte(wc * 32 + fr, fq * 8);
#define G_SA(b, h) (((b) * 2 + (h)) * HTB)
#define G_SB(b, h) ((4 + (b) * 2 + (h)) * HTB)
#define G_STAGE(bufoff, gbase, voff) do { _Pragma("unroll") for (int _i = 0; _i < 2; ++_i) \
        __builtin_amdgcn_global_load_lds((const unsigned*)((const char*)(gbase) + (voff)[_i]), (LAS unsigned*)(lds + (bufoff) + ldsw + _i * 8192), 16, 0, 0); } while (0)
#define G_LDA(dst, b, h) do { _Pragma("unroll") for (int m = 0; m < 4; ++m) _Pragma("unroll") for (int k = 0; k < 2; ++k) dst[m][k] = *(const LAS h16x8*)(lds + G_SA(b, h) + aoff + m * 2048 + k * 1024); } while (0)
#define G_LDB(dst, b, h) do { _Pragma("unroll") for (int n = 0; n < 2; ++n) _Pragma("unroll") for (int k = 0; k < 2; ++k) dst[n][k] = *(const LAS h16x8*)(lds + G_SB(b, h) + boff + n * 2048 + k * 1024); } while (0)
#define G_MMA(ai, bj, At, Bt) do { __builtin_amdgcn_s_setprio(1); _Pragma("unroll") for (int m = 0; m < 4; ++m) _Pragma("unroll") for (int n = 0; n < 2; ++n) _Pragma("unroll") for (int k = 0; k < 2; ++k) \
        acc[ai][bj][m][n] = __builtin_amdgcn_mfma_f32_16x16x32_f16(Bt[n][k], At[m][k], acc[ai][bj][m][n], 0, 0, 0); __builtin_amdgcn_s_setprio(0); } while (0)
#define G_WAIT_V(n) asm volatile("s_waitcnt vmcnt(" #n ")" ::: "memory")
#define G_WAIT_L(n) asm volatile("s_waitcnt lgkmcnt(" #n ")" ::: "memory")
#define G_BAR __builtin_amdgcn_s_barrier()
#define G_SCHED __builtin_amdgcn_sched_barrier(0)
    Unit cur, nxt; int ui = 0;
    if (!unit_next(g, 0, cur)) return;
    f32x4 acc[2][2][4][2];
#pragma unroll
    for (int a = 0; a < 2; ++a)
#pragma unroll
        for (int b = 0; b < 2; ++b)
#pragma unroll
            for (int m = 0; m < 4; ++m)
#pragma unroll
                for (int n = 0; n < 2; ++n) acc[a][b][m][n] = (f32x4){0.f, 0.f, 0.f, 0.f};
    h16x8 At[4][2], B0[2][2], B1[2][2];
    const char* cA = (const char*)(g.A + (size_t)cur.pb * g.strideA) + (size_t)cur.pm * 2 * hstepA;
    const char* cB = (const char*)(g.Bt + (size_t)cur.pb * g.strideB) + (size_t)cur.pn * 2 * hstepB;
    G_STAGE(G_SB(0, 0), cB, voffB); G_STAGE(G_SA(0, 0), cA, voffA); G_STAGE(G_SB(0, 1), cB + hstepB, voffB); G_STAGE(G_SA(0, 1), cA + hstepA, voffA);
    if (wr == 1) G_BAR;
    G_WAIT_V(4); G_BAR;
    G_STAGE(G_SB(1, 0), cB + kstep, voffB); G_STAGE(G_SA(1, 0), cA + kstep, voffA); G_STAGE(G_SB(1, 1), cB + hstepB + kstep, voffB);
    G_WAIT_V(6); G_BAR;
    for (;;) {
        const bool has_next = unit_next(g, ui + 1, nxt);
        const char* nA = has_next ? (const char*)(g.A + (size_t)nxt.pb * g.strideA) + (size_t)nxt.pm * 2 * hstepA : cA;
        const char* nB = has_next ? (const char*)(g.Bt + (size_t)nxt.pb * g.strideB) + (size_t)nxt.pn * 2 * hstepB : cB;
        for (int t = 0; t < nt; t += 2) {
            const bool last = (t == nt - 2);
            const char* a1 = cA + (size_t)(t + 1) * kstep;
            const char* a2 = last ? nA : cA + (size_t)(t + 2) * kstep; const char* b2 = last ? nB : cB + (size_t)(t + 2) * kstep;
            const char* a3 = a2 + kstep; const char* b3 = b2 + kstep;
            G_LDB(B0, 0, 0); G_SCHED; G_LDA(At, 0, 0); G_STAGE(G_SA(1, 1), a1 + hstepA, voffA);
            G_WAIT_L(8); G_BAR; G_WAIT_L(0); G_MMA(0, 0, At, B0); G_BAR; G_SCHED;
            G_LDB(B1, 0, 1); G_STAGE(G_SB(0, 0), b2, voffB);
            G_BAR; G_WAIT_L(0); G_MMA(0, 1, At, B1); G_BAR;
            G_LDA(At, 0, 1); G_STAGE(G_SA(0, 0), a2, voffA);
            G_BAR; G_WAIT_L(0); G_MMA(1, 0, At, B0); G_BAR; G_SCHED;
            G_STAGE(G_SB(0, 1), b2 + hstepB, voffB);
            G_WAIT_V(6); G_BAR; G_MMA(1, 1, At, B1); G_BAR;
            G_LDB(B0, 1, 0); G_SCHED; G_LDA(At, 1, 0); G_STAGE(G_SA(0, 1), a2 + hstepA, voffA);
            G_WAIT_L(8); G_BAR; G_WAIT_L(0); G_MMA(0, 0, At, B0); G_BAR; G_SCHED;
            G_LDB(B1, 1, 1); G_STAGE(G_SB(1, 0), b3, voffB);
            G_BAR; G_WAIT_L(0); G_MMA(0, 1, At, B1); G_BAR;
            G_LDA(At, 1, 1); G_STAGE(G_SA(1, 0), a3, voffA);
            G_BAR; G_WAIT_L(0); G_MMA(1, 0, At, B0); G_BAR; G_SCHED;
            G_STAGE(G_SB(1, 1), b3 + hstepB, voffB);
            G_WAIT_V(6); G_BAR; G_MMA(1, 1, At, B1); G_BAR;
        }
        epilogue<MODE>(acc, cur, E, wr, wc, fr, fq);
        if (!has_next) break;
#pragma unroll
        for (int a = 0; a < 2; ++a)
#pragma unroll
            for (int b = 0; b < 2; ++b)
#pragma unroll
                for (int m = 0; m < 4; ++m)
#pragma unroll
                    for (int n = 0; n < 2; ++n) acc[a][b][m][n] = (f32x4){0.f, 0.f, 0.f, 0.f};
        cur = nxt; cA = nA; cB = nB; ++ui;
    }
    G_WAIT_V(0);
    if (wr == 0) G_BAR;
    G_BAR;
#undef G_SA
#undef G_SB
#undef G_STAGE
#undef G_LDA
#undef G_LDB
#undef G_MMA
#undef G_WAIT_V
#undef G_WAIT_L
#undef G_BAR
#undef G_SCHED
}

__device__ __forceinline__ void tr_tile(const float* src, int N, int ldsrc, h16* dst, int lddst, int mode, int kb, int nb, float* scr) {
    const int t = threadIdx.x, k0 = kb * 64, n0 = nb * 64;
    { const int nl = t & 63, kl0 = t >> 6;
#pragma unroll
      for (int i = 0; i < 8; ++i) { const int kl = kl0 + 8 * i; scr[kl * 65 + nl] = (n0 + nl < N) ? src[(size_t)(k0 + kl) * ldsrc + n0 + nl] : 0.f; } }
    __syncthreads();
    { const int kp = t & 31, nl0 = t >> 5;
#pragma unroll
      for (int i = 0; i < 4; ++i) { const int nl = nl0 + 16 * i, n = n0 + nl;
          const int row = mode == 0 ? n : ((n >> 7) * 256 + ((n >> 2) & 1) * 128 + ((n >> 5) & 3) * 32 + (mode == 2 ? 16 : 0) + ((n >> 3) & 3) * 4 + (n & 3));
          h16x2 v; v.x = (h16)scr[(2 * kp) * 65 + nl]; v.y = (h16)scr[(2 * kp + 1) * 65 + nl];
          *(h16x2*)(dst + (size_t)row * lddst + k0 + 2 * kp) = v; } }
    __syncthreads();
}

__device__ __forceinline__ void prep_transposes(const Params& P, float* scr) {
    unsigned char* ws = P.ws;
    constexpr int T_FFN = 704, N_FFN = 24 * T_FFN, T_PP = 64, T_SQ = 256, T_ABIN = 512, T_GLU = 64, T_CIN = 576;
    constexpr int TOTAL = N_FFN + 4 * T_PP + 4 * T_SQ + 2 * T_ABIN + 2 * T_SQ + 2 * T_GLU + 2 * T_CIN + 2 * T_SQ;
    constexpr int T1 = 12160;
    const int nb2 = (int)gridDim.x > 64 ? (int)gridDim.x - 64 : (int)gridDim.x;
    for (int it0 = blockIdx.x; ; ) {
        int it;
        if (it0 < T1) { it = it0; it0 += gridDim.x; if (it0 >= T1) it0 = (blockIdx.x >= 64 || gridDim.x <= 64) ? T1 + ((int)blockIdx.x >= 64 ? (int)blockIdx.x - 64 : (int)blockIdx.x) : TOTAL; }
        else { it = it0; it0 += nb2; }
        if (it >= TOTAL) break;
        int r = it;
        if (r < N_FFN) { const int mtx = r / T_FFN, tl = r % T_FFN, which = mtx / 8, li = mtx % 8;
            if (which == 0) tr_tile(P.w1 + (size_t)li * 1024 * 2816, 2816, 2816, (h16*)(ws + OFF_W13 + li * SZ_W13), 1024, 1, tl / 44, tl % 44, scr);
            else if (which == 1) tr_tile(P.w3 + (size_t)li * 1024 * 2816, 2816, 2816, (h16*)(ws + OFF_W13 + li * SZ_W13), 1024, 2, tl / 44, tl % 44, scr);
            else tr_tile(P.w2 + (size_t)li * 2816 * 1024, 1024, 1024, (h16*)(ws + OFF_W2T + li * SZ_W2T), 2816, 0, tl / 16, tl % 16, scr);
            continue; } r -= N_FFN;
        if (r < 4 * T_PP) { const int i = r / T_PP, tl = r % T_PP; tr_tile(P.plep + (size_t)i * 256 * 1024, 1024, 1024, (h16*)(ws + OFF_WPT + i * SZ_WPT), 256, 0, tl / 16, tl % 16, scr); continue; } r -= 4 * T_PP;
        if (r < 4 * T_SQ) { const int i = r / T_SQ, tl = r % T_SQ; tr_tile(P.pleg + (size_t)i * 1024 * 1024, 1024, 1024, (h16*)(ws + OFF_WGT + i * SZ_SQ), 1024, 0, tl / 16, tl % 16, scr); continue; } r -= 4 * T_SQ;
        if (r < 2 * T_ABIN) { const int i = r / T_ABIN, tl = r % T_ABIN; tr_tile(P.abin + (size_t)i * 1024 * 2048, 2048, 2048, (h16*)(ws + OFF_ABIN + i * SZ_ABIN), 1024, 0, tl / 32, tl % 32, scr); continue; } r -= 2 * T_ABIN;
        if (r < 2 * T_SQ) { const int i = r / T_SQ, tl = r % T_SQ; tr_tile(P.about + (size_t)i * 1024 * 1024, 1024, 1024, (h16*)(ws + OFF_ABOUT + i * SZ_SQ), 1024, 0, tl / 16, tl % 16, scr); continue; } r -= 2 * T_SQ;
        if (r < 2 * T_GLU) { const int i = r / T_GLU, tl = r % T_GLU; tr_tile(P.wglu + (size_t)i * 512 * 512, 512, 512, (h16*)(ws + OFF_WGLU + i * SZ_WGLU), 512, 0, tl / 8, tl % 8, scr); continue; } r -= 2 * T_GLU;
        if (r < 2 * T_CIN) { const int i = r / T_CIN, tl = r % T_CIN; tr_tile(P.cin + (size_t)i * 1024 * 2120, 2120, 2120, (h16*)(ws + OFF_CIN + i * SZ_CIN), 1024, 0, tl / 36, tl % 36, scr); continue; } r -= 2 * T_CIN;
        { const int i = r / T_SQ, tl = r % T_SQ; tr_tile(P.cout + (size_t)i * 1024 * 1024, 1024, 1024, (h16*)(ws + OFF_COUT + i * SZ_SQ), 1024, 0, tl / 16, tl % 16, scr); }
    }
}

__device__ __forceinline__ void s5_build(const Params& P, int j, int g, float* L) {
    float* abr = L;
    float* abi = L + 2112;
    float* bbr = L + 4224;
    float* bbi = L + 5248;
    float* ccr = L + 6272;
    float* cci = L + 7296;
    float* fre = L + 8320;
    float* fim = L + 8384;
    float* Kt = L + 8448;
    const int tid = threadIdx.x, jg = j * 32 + g;
    if (tid < 64) {
        const int p = tid;
        const float lr = fminf(P.lamre[jg * 64 + p], -1e-4f), li = P.lamim[jg * 64 + p], dt = expf(P.logdt[jg]);
        const float mag = expf(lr * dt), are = mag * cosf(li * dt), aim = mag * sinf(li * dt);
        const float nr = are - 1.f, ni = aim, den = lr * lr + li * li;
        fre[p] = (nr * lr + ni * li) / den; fim[p] = (ni * lr - nr * li) / den;
        float pr = 1.f, pi = 0.f;
        for (int d = 0; d <= 32; ++d) { abr[d * 64 + p] = pr; abi[d * 64 + p] = pi; const float t = pr * are - pi * aim; pi = pr * aim + pi * are; pr = t; }
    }
    __syncthreads();
    for (int e = tid; e < 1024; e += 512) {
        const int p = e >> 4;
        const float br = P.bre[(size_t)jg * 1024 + e], bi = P.bim[(size_t)jg * 1024 + e];
        bbr[e] = fre[p] * br - fim[p] * bi; bbi[e] = fre[p] * bi + fim[p] * br;
        ccr[e] = P.cre[(size_t)jg * 1024 + e]; cci[e] = P.cim[(size_t)jg * 1024 + e];
    }
    __syncthreads();
    for (int e = tid; e < 8192; e += 512) {
        const int d = e >> 8, co = (e >> 4) & 15, ci = e & 15; float s = 0.f;
        for (int p = 0; p < 64; ++p) {
            const float ar = abr[d * 64 + p], ai = abi[d * 64 + p], br = bbr[p * 16 + ci], bi = bbi[p * 16 + ci];
            const float wr_ = ar * br - ai * bi, wi_ = ar * bi + ai * br;
            s += ccr[co * 64 + p] * wr_ - cci[co * 64 + p] * wi_;
        }
        Kt[e] = s * 1024.f;
    }
    __syncthreads();
    h16* W1 = (h16*)(P.ws + OFF_W1M + (size_t)j * SZ_W1M) + (size_t)g * 256 * 512;
    for (int e = tid; e < 128 * 256; e += 512) {
        const int n = e >> 8, k = (e & 255) * 2, tau = k >> 4, ci = k & 15, p = n & 63, d = 31 - tau;
        const float ar = abr[d * 64 + p], ai = abi[d * 64 + p]; h16x2 v;
        if (n < 64) { v.x = (h16)(1024.f * (ar * bbr[p * 16 + ci] - ai * bbi[p * 16 + ci])); v.y = (h16)(1024.f * (ar * bbr[p * 16 + ci + 1] - ai * bbi[p * 16 + ci + 1])); }
        else { v.x = (h16)(1024.f * (ar * bbi[p * 16 + ci] + ai * bbr[p * 16 + ci])); v.y = (h16)(1024.f * (ar * bbi[p * 16 + ci + 1] + ai * bbr[p * 16 + ci + 1])); }
        *(h16x2*)(W1 + (size_t)n * 512 + k) = v;
        h16x2 z; z.x = (h16)0.f; z.y = (h16)0.f; *(h16x2*)(W1 + (size_t)(128 + n) * 512 + k) = z;
    }
    h16* M2 = (h16*)(P.ws + OFF_M2 + (size_t)j * SZ_M2) + (size_t)g * 512 * 640;
    for (int e = tid; e < 512 * 320; e += 512) {
        const int n = e / 320, k = (e % 320) * 2, t = n >> 4, co = n & 15; h16x2 v;
        if (k < 512) { const int tau = k >> 4, ci = k & 15;
            if (tau <= t) { v.x = (h16)Kt[(t - tau) * 256 + co * 16 + ci]; v.y = (h16)Kt[(t - tau) * 256 + co * 16 + ci + 1]; } else { v.x = (h16)0.f; v.y = (h16)0.f; } }
        else if (k < 576) { const int p = k - 512;
            v.x = (h16)(ccr[co * 64 + p] * abr[(t + 1) * 64 + p] - cci[co * 64 + p] * abi[(t + 1) * 64 + p]);
            v.y = (h16)(ccr[co * 64 + p + 1] * abr[(t + 1) * 64 + p + 1] - cci[co * 64 + p + 1] * abi[(t + 1) * 64 + p + 1]); }
        else { const int p = k - 576;
            v.x = (h16)(-(ccr[co * 64 + p] * abi[(t + 1) * 64 + p] + cci[co * 64 + p] * abr[(t + 1) * 64 + p]));
            v.y = (h16)(-(ccr[co * 64 + p + 1] * abi[(t + 1) * 64 + p + 1] + cci[co * 64 + p + 1] * abr[(t + 1) * 64 + p + 1])); }
        *(h16x2*)(M2 + (size_t)n * 640 + k) = v;
    }
    if (tid < 64) { f32x2 a; a.x = abr[32 * 64 + tid]; a.y = abi[32 * 64 + tid]; *(f32x2*)(P.ws + OFF_A32 + ((size_t)jg * 64 + tid) * 8) = a; }
    __syncthreads();
}

__device__ __forceinline__ void ln_pass(h16* Y16, const float* g, const float* b) {
    int tid_ = threadIdx.x; asm volatile("" : "+v"(tid_));
    const int lane = tid_ & 63, wave = tid_ >> 6;
    f32x4 gv[4], bv[4];
#pragma unroll
    for (int j = 0; j < 2; ++j)
#pragma unroll
        for (int q = 0; q < 2; ++q) { gv[2 * j + q] = *(const f32x4*)(g + 8 * lane + 512 * j + 4 * q); bv[2 * j + q] = *(const f32x4*)(b + 8 * lane + 512 * j + 4 * q); }
    for (int row0 = (blockIdx.x * 8 + wave) * 4; row0 < NTOK; row0 += gridDim.x * 32) {
        h16x8 w[4][2];
#pragma unroll
        for (int r = 0; r < 4; ++r)
#pragma unroll
            for (int j = 0; j < 2; ++j) w[r][j] = *(const h16x8*)(Y16 + (size_t)(row0 + r) * DM + 8 * lane + 512 * j);
#pragma unroll
        for (int r = 0; r < 4; ++r) {
            h16* yr = Y16 + (size_t)(row0 + r) * DM + 8 * lane; f32x4 v[4]; float s = 0.f;
#pragma unroll
            for (int j = 0; j < 2; ++j) {
                v[2 * j] = (f32x4){(float)w[r][j][0], (float)w[r][j][1], (float)w[r][j][2], (float)w[r][j][3]}; v[2 * j + 1] = (f32x4){(float)w[r][j][4], (float)w[r][j][5], (float)w[r][j][6], (float)w[r][j][7]}; }
#pragma unroll
            for (int j = 0; j < 4; ++j) s += (v[j].x + v[j].y) + (v[j].z + v[j].w);
            const float mean = wave_sum(s) * (1.f / DM); float s2 = 0.f;
#pragma unroll
            for (int j = 0; j < 4; ++j) { v[j] = v[j] - mean; s2 += (v[j].x * v[j].x + v[j].y * v[j].y) + (v[j].z * v[j].z + v[j].w * v[j].w); }
            const float rstd = 1.f / sqrtf(wave_sum(s2) * (1.f / DM) + LN_EPS);
#pragma unroll
            for (int j = 0; j < 2; ++j) { const f32x4 o0 = v[2 * j] * rstd * gv[2 * j] + bv[2 * j], o1 = v[2 * j + 1] * rstd * gv[2 * j + 1] + bv[2 * j + 1]; h16x8 o;
                o[0] = (h16)o0.x; o[1] = (h16)o0.y; o[2] = (h16)o0.z; o[3] = (h16)o0.w; o[4] = (h16)o1.x; o[5] = (h16)o1.y; o[6] = (h16)o1.z; o[7] = (h16)o1.w;
                *(h16x8*)(yr + 512 * j) = o; }
        }
    }
}

__device__ __forceinline__ void cvt_pass(const float* src, h16* dst, size_t n, float* dup) {
    for (size_t i = ((size_t)blockIdx.x * 512 + threadIdx.x) * 8; i < n; i += (size_t)gridDim.x * 512 * 8) {
        const f32x4 a = *(const f32x4*)(src + i), b = *(const f32x4*)(src + i + 4);
        h16x8 o; o[0] = (h16)a.x; o[1] = (h16)a.y; o[2] = (h16)a.z; o[3] = (h16)a.w; o[4] = (h16)b.x; o[5] = (h16)b.y; o[6] = (h16)b.z; o[7] = (h16)b.w;
        *(h16x8*)(dst + i) = o;
        if (dup) { *(f32x4*)(dup + i) = a; *(f32x4*)(dup + i + 4) = b; }
    }
}

__device__ __forceinline__ void conv_pass(const h16* PE, const float* cw, h16* MIXA) {
    for (size_t i = (size_t)blockIdx.x * 512 + threadIdx.x; i < (size_t)NTOK * 64; i += (size_t)gridDim.x * 512) {
        const int row = (int)(i >> 6), c = (int)(i & 63) * 8, l = row & (SEQ - 1);
        const h16* pr = PE + (size_t)row * 1536 + c;
        const h16x8 h0 = *(const h16x8*)pr, gb = *(const h16x8*)(pr + 512), g0 = *(const h16x8*)(pr + 1024);
        h16x8 h1, g1, h2, g2;
        if (l >= 1) { h1 = *(const h16x8*)(pr - 1536); g1 = *(const h16x8*)(pr - 1536 + 1024); }
        if (l >= 2) { h2 = *(const h16x8*)(pr - 3072); g2 = *(const h16x8*)(pr - 3072 + 1024); }
        h16x8 o;
#pragma unroll
        for (int e = 0; e < 8; ++e) {
            float v = cw[1024 + c + e] * ((float)g0[e] * (float)h0[e]);
            if (l >= 1) v += cw[512 + c + e] * ((float)g1[e] * (float)h1[e]);
            if (l >= 2) v += cw[c + e] * ((float)g2[e] * (float)h2[e]);
            o[e] = (h16)((float)gb[e] * v);
        }
        *(h16x8*)(MIXA + (size_t)row * DM + c) = o;
    }
}
__device__ __forceinline__ void carry_pass(const float* SLOC, h16* UG, const float* A32) {
    int tid_ = threadIdx.x; asm volatile("" : "+v"(tid_));
    const int gid = blockIdx.x * 512 + tid_;
    if (gid >= NBATCH * 32 * 64) return;
    const int p = gid & 63, g = (gid >> 6) & 31, b = gid >> 11;
    const f32x2 a = *(const f32x2*)(A32 + ((size_t)g * 64 + p) * 2);
    float sr = 0.f, si = 0.f;
    const size_t row0 = (size_t)g * 1024 + b * 256;
    for (int c0 = 0; c0 < 256; c0 += 8) {
        float xr[8], xi[8];
#pragma unroll
        for (int k = 0; k < 8; ++k) { xr[k] = SLOC[(row0 + c0 + k) * 128 + p]; xi[k] = SLOC[(row0 + c0 + k) * 128 + 64 + p]; }
#pragma unroll
        for (int k = 0; k < 8; ++k) {
            h16* ur = UG + (row0 + c0 + k) * 640 + 512 + p; ur[0] = (h16)(sr * 1024.f); ur[64] = (h16)(si * 1024.f);
            const float t = a.x * sr - a.y * si + xr[k]; si = a.x * si + a.y * sr + xi[k]; sr = t;
        }
    }
}

#define XB_TMO      128
#define XB_XCNT(j)  (256  + 64 * (j))
#define XB_XSUB(j)  (1280 + 64 * (j))
#define XB_XGEN(j)  (2304 + 64 * (j))
#define XB_TOP      3328
#define XB_TOPGEN   3392
#define XCD_BAR_WORDS 3456
#define XB_SPIN_CAP (1u << 22)
__device__ __forceinline__ unsigned xb_ld(unsigned* p)              { return __hip_atomic_load(p, __ATOMIC_RELAXED, __HIP_MEMORY_SCOPE_AGENT); }
__device__ __forceinline__ unsigned xb_add(unsigned* p, unsigned v) { return __hip_atomic_fetch_add(p, v, __ATOMIC_RELAXED, __HIP_MEMORY_SCOPE_AGENT); }
__device__ __forceinline__ unsigned xb_xcc_id() { return (unsigned)__builtin_amdgcn_s_getreg((3 << 11) | 20) & 0xFu; }
#define XB_SPIN(cond, bar) do { unsigned _sp = 0; while (cond) { __builtin_amdgcn_s_sleep(1); \
    if ((++_sp & 255u) == 0u) { if (xb_ld(&(bar)[XB_TMO])) break; if (_sp > XB_SPIN_CAP) { atomicAdd(&(bar)[XB_TMO], 1u); break; } } } } while (0)
__device__ __forceinline__ void xcd_barrier_complete(unsigned* bar, unsigned x, unsigned& nloc, unsigned& nx) {
    const unsigned G = gridDim.x;
    unsigned sum, cnt, mine, sp = 0u;
    for (;;) {
        sum = 0u; cnt = 0u; mine = 0u;
#pragma unroll
        for (unsigned j = 0; j < 16; ++j) { const unsigned c = xb_ld(&bar[XB_XCNT(j)]); sum += c; cnt += (c > 0u) ? 1u : 0u; mine = (j == x) ? c : mine; }
        if (sum == G) break;
        __builtin_amdgcn_s_sleep(1);
        if ((++sp & 255u) == 0u) { if (xb_ld(&bar[XB_TMO])) break; if (sp > XB_SPIN_CAP) { atomicAdd(&bar[XB_TMO], 1u); break; } }
    }
    nloc = mine > 0u ? mine : 1u; nx = cnt > 0u ? cnt : 1u;
}
__device__ __forceinline__ void xcd_barrier(unsigned* bar, volatile LAS unsigned* st) {
    asm volatile("s_waitcnt vmcnt(0)" ::: "memory");
    __syncthreads();
    if (threadIdx.x == 0) {
        const unsigned x = xb_xcc_id();
        __builtin_amdgcn_s_waitcnt(0);
        unsigned nloc = st[0], nx = st[1];
        if (nloc == 0u) { xcd_barrier_complete(bar, x, nloc, nx); st[0] = nloc; st[1] = nx; }
        const unsigned old = xb_add(&bar[XB_XSUB(x)], 1u);
        const unsigned gen = old / nloc;
        if (old + 1u == (gen + 1u) * nloc) {
            __builtin_amdgcn_fence(__ATOMIC_RELEASE, "agent");
            asm volatile("s_waitcnt vmcnt(0)" ::: "memory");
            const unsigned og = xb_add(&bar[XB_TOP], 1u);
            const unsigned tg = og / nx;
            if (og + 1u == (tg + 1u) * nx) xb_add(&bar[XB_TOPGEN], 1u);
            else XB_SPIN(xb_ld(&bar[XB_TOPGEN]) == tg, bar);
            __builtin_amdgcn_fence(__ATOMIC_ACQUIRE, "agent");
            xb_add(&bar[XB_XGEN(x)], 1u);
            asm volatile("s_waitcnt vmcnt(0)" ::: "memory");
        } else {
            XB_SPIN(xb_ld(&bar[XB_XGEN(x)]) == gen, bar);
            __builtin_amdgcn_fence(__ATOMIC_ACQUIRE, "agent");
            asm volatile("s_waitcnt vmcnt(0)" ::: "memory");
        }
    }
    __syncthreads();
}

__device__ __forceinline__ bool xcd_unit_rank(unsigned* bar, unsigned x, unsigned r, int U, int u, int& rank, int& total) {
    unsigned c[16];
#pragma unroll
    for (int j = 0; j < 16; ++j) c[j] = xb_ld(&bar[XB_XCNT(j)]);
    int nx = 0, myo = 0;
#pragma unroll
    for (int j = 0; j < 16; ++j) if (c[j]) { if ((unsigned)j < x) ++myo; ++nx; }
    const int m = nx < U ? nx : U, um = u % m;
    if (myo % m != um) return false;
    int ord = 0; rank = (int)r; total = 0;
#pragma unroll
    for (int j = 0; j < 16; ++j) if (c[j]) { if (ord % m == um) { total += (int)c[j]; if ((unsigned)j < x) rank += (int)c[j]; } ++ord; }
    return true;
}

template <int PASS>
__device__ __forceinline__ void idx_tiles(const unsigned char* buf, int Tbase, int tq, int fr, int fq, const h16x8 (&aq)[2][2], const float (&wv)[8], const h16x2 (&wp)[4],
                                          unsigned* myhist, unsigned b0, unsigned* myctl, unsigned* mycand, unsigned short* out) {
    const int sw = (fr >> 1) & 7;
    const unsigned char* lp = buf + fr * 128;
#pragma unroll
    for (int hb = 0; hb < 2; ++hb) {
        h16x8 kf[8][2];
#pragma unroll
        for (int e = 0; e < 8; ++e) { const unsigned char* tp = lp + (hb * 8 + e) * 2048; kf[e][0] = *(const h16x8*)(tp + ((fq ^ sw) << 4)); kf[e][1] = *(const h16x8*)(tp + (((fq + 4) ^ sw) << 4)); }
#pragma unroll
        for (int e = 0; e < 8; ++e) { const int T = Tbase + hb * 8 + e;
            f32x4 a0 = (f32x4){0.f, 0.f, 0.f, 0.f}, a1 = a0;
            a0 = __builtin_amdgcn_mfma_f32_16x16x32_f16(aq[0][0], kf[e][0], a0, 0, 0, 0); a0 = __builtin_amdgcn_mfma_f32_16x16x32_f16(aq[0][1], kf[e][1], a0, 0, 0, 0);
            a1 = __builtin_amdgcn_mfma_f32_16x16x32_f16(aq[1][0], kf[e][0], a1, 0, 0, 0); a1 = __builtin_amdgcn_mfma_f32_16x16x32_f16(aq[1][1], kf[e][1], a1, 0, 0, 0);
            const h16x2 z2 = (h16x2){(h16)0.f, (h16)0.f};
            const h16x2 r0 = __builtin_elementwise_max(__builtin_bit_cast(h16x2, __builtin_amdgcn_cvt_pkrtz(a0[0], a0[1])), z2), r1 = __builtin_elementwise_max(__builtin_bit_cast(h16x2, __builtin_amdgcn_cvt_pkrtz(a0[2], a0[3])), z2);
            const h16x2 r2 = __builtin_elementwise_max(__builtin_bit_cast(h16x2, __builtin_amdgcn_cvt_pkrtz(a1[0], a1[1])), z2), r3 = __builtin_elementwise_max(__builtin_bit_cast(h16x2, __builtin_amdgcn_cvt_pkrtz(a1[2], a1[3])), z2);
            const float sa = __builtin_amdgcn_fdot2(r0, wp[0], __builtin_amdgcn_fdot2(r1, wp[1], __builtin_amdgcn_fdot2(r2, wp[2], __builtin_amdgcn_fdot2(r3, wp[3], 0.f, false), false), false), false);
            const int key = 16 * T + fr;
            if (key <= tq) {
                const unsigned bin = (unsigned)(int)fminf(fmaxf(sa * 32.f + 128.f, 0.f), 255.f);
                if (PASS == 1) { if (bin >= b0) atomicAdd(&myhist[fq * 256 + bin], 1u); }
                else {
                    if (bin > b0) { const unsigned pos = atomicAdd(&myctl[fq * 4 + 2], 1u); ((unsigned short*)myhist)[fq * 256 + (pos & 255u)] = (unsigned short)key; }
                    else if (bin == b0) { const unsigned c = atomicAdd(&myctl[fq * 4 + 3], 1u);
                        if (c < 128u) { float s = 0.f;
#pragma unroll
                            for (int r = 0; r < 4; ++r) s += wv[r] * fmaxf(a0[r], 0.f) + wv[4 + r] * fmaxf(a1[r], 0.f);
                            s = fminf(fmaxf(s, -3.99f), 3.99f);
                            mycand[(fq * 128 + c) * 2] = (unsigned)((s + 4.f) * 536870912.f); mycand[(fq * 128 + c) * 2 + 1] = (unsigned)key; } }
                }
            }
        }
        __builtin_amdgcn_sched_barrier(0);
    }
}
template <int PASS, bool SAMPLE>
__device__ __forceinline__ void idx_sweep(const h16* KIb, int nch, unsigned char* stage, int tid, int tq, int fr, int fq, const h16x8 (&aq)[2][2], const float (&wv)[8], const h16x2 (&wp)[4],
                                          unsigned* myhist, unsigned b0, unsigned* myctl, unsigned* mycand, unsigned short* out) {
    int loff[4];
#pragma unroll
    for (int i = 0; i < 4; ++i) { const int o = (tid + 512 * i) * 16, R = o >> 7, c16 = (o >> 4) & 7, r = R & 15; loff[i] = (R >> 4) * 2048 + r * 128 + ((c16 ^ ((r >> 1) & 7)) << 4); }
    const unsigned char* src = (const unsigned char*)KIb + tid * 16;
    h16x8 st[4];
    const int rot = (int)((blockIdx.x * 7u) % (unsigned)nch);
#pragma unroll
    for (int i = 0; i < 4; ++i) st[i] = *(const h16x8*)(src + (size_t)rot * 32768 + 8192 * i);
#pragma unroll
    for (int i = 0; i < 4; ++i) *(h16x8*)(stage + loff[i]) = st[i];
    __syncthreads();
    for (int c = 0; c < nch; ++c) {
        const bool more = (c + 1) < nch;
        int cc = c + rot; cc = cc >= nch ? cc - nch : cc;
        int cn = cc + 1; cn = cn >= nch ? 0 : cn;
        if (more) {
#pragma unroll
            for (int i = 0; i < 4; ++i) st[i] = *(const h16x8*)(src + (size_t)cn * 32768 + 8192 * i); }
        idx_tiles<PASS>(stage + (c & 1) * 32768, cc * 16, tq, fr, fq, aq, wv, wp, myhist, b0, myctl, mycand, out);
        if (PASS == 1 && SAMPLE && c == 1 && nch > 2) {
            asm volatile("s_waitcnt lgkmcnt(0)" ::: "memory");
            const unsigned want = (unsigned)((tq + 1) < 256 ? (tq + 1) : 256);
            unsigned cnt[16]; unsigned lsum = 0u;
#pragma unroll
            for (int i = 0; i < 16; ++i) { cnt[i] = myhist[fq * 256 + fr * 16 + i]; lsum += cnt[i]; }
            unsigned incl = lsum;
#pragma unroll
            for (int o = 1; o < 16; o <<= 1) { const unsigned v = __shfl_down(incl, o); if (fr + o < 16) incl += v; }
            const unsigned ns = __shfl(incl, fq * 16);
            const unsigned target = (unsigned)(2.f * (float)want * (float)ns / (float)(tq + 1)) + 10u;
            const unsigned above = incl - lsum;
            if (fr == 0) myctl[fq * 4] = 0u;
            asm volatile("s_waitcnt lgkmcnt(0)" ::: "memory");
            if (target < ns && above < target && target <= incl) { unsigned cum = above; int bin = 0; bool found = false;
#pragma unroll
                for (int i = 15; i >= 0; --i) { if (!found) { if (cum + cnt[i] >= target) { bin = i; found = true; } else cum += cnt[i]; } }
                myctl[fq * 4] = (unsigned)(fr * 16 + bin); }
            asm volatile("s_waitcnt lgkmcnt(0)" ::: "memory");
            const unsigned fb = myctl[fq * 4];
            b0 = fb > 0u ? fb - 1u : 0u;
            if (fr == 0) myctl[fq * 4 + 1] = b0;
        }
        if (more) {
#pragma unroll
            for (int i = 0; i < 4; ++i) *(h16x8*)(stage + ((c + 1) & 1) * 32768 + loff[i]) = st[i]; }
        __syncthreads();
    }
}

__device__ __forceinline__ void dsa_select(const h16* PROJ, unsigned short* IDX, int* CNT, unsigned char* shm, unsigned* bar, unsigned xcc, unsigned xrank) {
    int tid_ = threadIdx.x; asm volatile("" : "+v"(tid_));
    const int tid = tid_, wid = tid >> 6, lane = tid & 63, fr = lane & 15, fq = lane >> 4;
    unsigned char* stage = shm;
    unsigned* myhist = (unsigned*)(shm + 65536) + wid * 1024;
    unsigned* mycand = (unsigned*)(shm + 98304) + wid * 1024;
    unsigned* myctl = (unsigned*)(shm + 131072) + wid * 16;
    for (int b = 0; b < NBATCH; ++b) {
        int rank, total; if (!xcd_unit_rank(bar, xcc, xrank, NBATCH, b, rank, total)) continue;
        const int nrounds = (256 + total - 1) / total;
        const h16* KIb = PROJ + O_KI + (size_t)b * SEQ * 64;
        for (int k = 0; k < nrounds; ++k) {
            const int it = k * total + ((k & 1) ? (total - 1 - rank) : rank);
            if (it >= 256) continue;
            const int tokbase = b * SEQ, t0 = it * 32 + wid * 4, tq = t0 + fq;
            const int nch = ((it * 32 + 31) / 16 + 1 + 15) / 16;
#pragma unroll
            for (int i = 0; i < 16; ++i) myhist[lane + 64 * i] = 0u;
            if (lane < 16) myctl[lane] = 0u;
            h16x8 aq[2][2];
            { const h16* qrow = PROJ + O_QI + (size_t)(tokbase + t0 + (fr >> 2)) * 512 + (fr & 3) * 64 + 8 * fq;
#pragma unroll
              for (int hh = 0; hh < 2; ++hh)
#pragma unroll
                  for (int kk = 0; kk < 2; ++kk) aq[hh][kk] = *(const h16x8*)(qrow + hh * 256 + kk * 32); }
            float wv[8];
            { const h16x8 w8 = *(const h16x8*)(PROJ + O_WI + (size_t)(tokbase + tq) * 8);
#pragma unroll
              for (int h = 0; h < 8; ++h) wv[h] = (float)w8[h] * 0.04419417382415922f; }
            h16x2 wp[4];
#pragma unroll
            for (int h = 0; h < 4; ++h) { wp[h].x = (h16)wv[(h >> 1) * 4 + (h & 1) * 2]; wp[h].y = (h16)wv[(h >> 1) * 4 + (h & 1) * 2 + 1]; }
            __builtin_amdgcn_s_waitcnt(0);
            unsigned short* out = IDX + (size_t)(tokbase + tq) * 256;
            unsigned* blkflag = (unsigned*)(shm + 131072 + 1024);
            if (tid == 0) *blkflag = 0u;
            idx_sweep<1, true>(KIb, nch, stage, tid, tq, fr, fq, aq, wv, wp, myhist, 0u, myctl, mycand, out);
            {
                unsigned tot = 0u; const unsigned flo = myctl[fq * 4 + 1];
#pragma unroll
                for (int i = 0; i < 16; ++i) { const unsigned cb = myhist[fq * 256 + fr * 16 + i]; tot += ((unsigned)(fr * 16 + i) >= flo) ? cb : 0u; }
#pragma unroll
                for (int o = 1; o < 16; o <<= 1) tot += __shfl_xor(tot, o);
                const unsigned want0 = (unsigned)((tq + 1) < 256 ? (tq + 1) : 256);
                if (tot < want0) *blkflag = 1u;
                __syncthreads();
                if (*blkflag != 0u) {
#pragma unroll
                    for (int i = 0; i < 16; ++i) myhist[lane + 64 * i] = 0u;
                    asm volatile("s_waitcnt lgkmcnt(0)" ::: "memory");
                    idx_sweep<1, false>(KIb, nch, stage, tid, tq, fr, fq, aq, wv, wp, myhist, 0u, myctl, mycand, out);
                }
            }
            { const unsigned want = (unsigned)((tq + 1) < 256 ? (tq + 1) : 256);
              unsigned c[16]; unsigned lsum = 0u;
#pragma unroll
              for (int i = 0; i < 16; ++i) { c[i] = myhist[fq * 256 + fr * 16 + i]; lsum += c[i]; }
              unsigned incl = lsum;
#pragma unroll
              for (int o = 1; o < 16; o <<= 1) { const unsigned v = __shfl_down(incl, o); if (fr + o < 16) incl += v; }
              const unsigned above = incl - lsum;
              if (above < want && want <= incl) { unsigned cum = above; int bin = 0; bool found = false;
#pragma unroll
                  for (int i = 15; i >= 0; --i) { if (!found) { if (cum + c[i] >= want) { bin = i; found = true; } else cum += c[i]; } }
                  myctl[fq * 4] = (unsigned)(fr * 16 + bin); myctl[fq * 4 + 1] = want - cum; } }
            asm volatile("s_waitcnt lgkmcnt(0)" ::: "memory");
            const unsigned b0 = myctl[fq * 4];
            idx_sweep<2, false>(KIb, nch, stage, tid, tq, fr, fq, aq, wv, wp, myhist, b0, myctl, mycand, out);
            { const unsigned nc = myctl[fq * 4 + 3], need = myctl[fq * 4 + 1]; const int n = (int)(nc < 128u ? nc : 128u);
              for (int ci = fr; ci < n; ci += 16) { const unsigned ki = mycand[(fq * 128 + ci) * 2], ii = mycand[(fq * 128 + ci) * 2 + 1]; unsigned rk = 0u;
                  for (int jx = 0; jx < n; ++jx) { const unsigned kj = mycand[(fq * 128 + jx) * 2], ij = mycand[(fq * 128 + jx) * 2 + 1]; rk += (kj > ki || (kj == ki && ij < ii)) ? 1u : 0u; }
                  if (rk < need) { const unsigned pos = atomicAdd(&myctl[fq * 4 + 2], 1u); ((unsigned short*)myhist)[fq * 256 + (pos & 255u)] = (unsigned short)ii; } } }
            asm volatile("s_waitcnt lgkmcnt(0)" ::: "memory");
            { const uint4* sp = (const uint4*)((const unsigned short*)myhist + fq * 256 + fr * 16); uint4* dp = (uint4*)(out + fr * 16); dp[0] = sp[0]; dp[1] = sp[1]; }
            if (fr == 0) CNT[tokbase + tq] = (int)myctl[fq * 4 + 2];
            __syncthreads();
        }
    }
}

__device__ __forceinline__ void dsa_attend(const h16* PROJ, const unsigned short* IDX, const int* CNT, h16* MIXA, unsigned char* shm, unsigned* bar, unsigned xcc, unsigned xrank) {
    float* Pl = (float*)shm;
    unsigned short* selw = (unsigned short*)(shm + 32768);
    int tid_ = threadIdx.x; asm volatile("" : "+v"(tid_));
    const int tid = tid_, wid = tid >> 6, lane = tid & 63, fr = lane & 15, fq = lane >> 4;
    unsigned short* sel = selw + wid * 256;
    const int qq = 0;
    for (int u = 0; u < 2 * NBATCH; ++u) {
        int rank, total; if (!xcd_unit_rank(bar, xcc, xrank, 2 * NBATCH, u, rank, total)) continue;
        const int b = u >> 1, g = u & 1, tokbase = b * SEQ;
        for (int it = rank; it < 1024; it += total) {
            const int t = it * 8 + wid, tokq = tokbase + t; int nsel = __builtin_amdgcn_readfirstlane(CNT[tokq]); nsel = nsel < 1 ? 1 : (nsel > 256 ? 256 : nsel);
            *(unsigned long long*)(sel + 4 * lane) = *(const unsigned long long*)(IDX + (size_t)tokq * 256 + 4 * lane);
            asm volatile("s_waitcnt vmcnt(0) lgkmcnt(0)" ::: "memory");
            h16x8 qa[4];
#pragma unroll
            for (int kk = 0; kk < 4; ++kk) { h16x8 z;
#pragma unroll
                for (int e = 0; e < 8; ++e) z[e] = (h16)0.f;
                qa[kk] = z; }
            if (fr < 4) { const h16* qrow = PROJ + O_Q + (size_t)tokq * 1024 + (g * 4 + fr) * 128 + 16 * fq;
#pragma unroll
                for (int kk = 0; kk < 4; ++kk) qa[kk] = *(const h16x8*)(qrow + (kk & 1) * 8 + (kk >> 1) * 64); }
            long qa8[4];
#pragma unroll
            for (int kk = 0; kk < 4; ++kk) {
                int w0 = __builtin_amdgcn_cvt_pk_fp8_f32((float)qa[kk][0], (float)qa[kk][1], 0, false); w0 = __builtin_amdgcn_cvt_pk_fp8_f32((float)qa[kk][2], (float)qa[kk][3], w0, true);
                int w1 = __builtin_amdgcn_cvt_pk_fp8_f32((float)qa[kk][4], (float)qa[kk][5], 0, false); w1 = __builtin_amdgcn_cvt_pk_fp8_f32((float)qa[kk][6], (float)qa[kk][7], w1, true);
                qa8[kk] = (long)(((unsigned long long)(unsigned)w1 << 32) | (unsigned long long)(unsigned)w0); }
            f32x4 sacc[16];
            const unsigned char* kbase8 = (const unsigned char*)(PROJ + O_KG) + (size_t)(b * 2 + g) * SEQ * 128 + 16 * fq;
            {
                uint4 kf[16][2];
#pragma unroll
                for (int e = 0; e < 16; ++e) { const int slot = 16 * e + fr; const int idx = (int)sel[qq * 256 + (slot < nsel ? slot : nsel - 1)];
                    const unsigned char* krow = kbase8 + (size_t)idx * 128;
                    kf[e][0] = *(const uint4*)krow; kf[e][1] = *(const uint4*)(krow + 64); }
                __builtin_amdgcn_sched_barrier(0);
#pragma unroll
                for (int e = 0; e < 16; ++e) {
                    f32x4 a = (f32x4){0.f, 0.f, 0.f, 0.f};
#pragma unroll
                    for (int L = 0; L < 2; ++L) {
                        const long k0 = (long)(((unsigned long long)kf[e][L].y << 32) | (unsigned long long)kf[e][L].x), k1 = (long)(((unsigned long long)kf[e][L].w << 32) | (unsigned long long)kf[e][L].z);
                        a = __builtin_amdgcn_mfma_f32_16x16x32_fp8_fp8(qa8[2 * L], k0, a, 0, 0, 0); a = __builtin_amdgcn_mfma_f32_16x16x32_fp8_fp8(qa8[2 * L + 1], k1, a, 0, 0, 0); }
                    if (16 * e + fr >= nsel) a = (f32x4){-1e30f, -1e30f, -1e30f, -1e30f};
                    sacc[e] = a; }
                __builtin_amdgcn_sched_barrier(0);
            }
            f32x4 mx = sacc[0];
#pragma unroll
            for (int jt = 1; jt < 16; ++jt)
#pragma unroll
                for (int i = 0; i < 4; ++i) mx[i] = fmaxf(mx[i], sacc[jt][i]);
#pragma unroll
            for (int o = 1; o < 16; o <<= 1)
#pragma unroll
                for (int i = 0; i < 4; ++i) mx[i] = fmaxf(mx[i], __shfl_xor(mx[i], o));
            f32x4 sm = (f32x4){0.f, 0.f, 0.f, 0.f};
            const float sc = 0.08838834764831845f;
#pragma unroll
            for (int jt = 0; jt < 16; ++jt)
#pragma unroll
                for (int i = 0; i < 4; ++i) { const float e = __expf((sacc[jt][i] - mx[i]) * sc); sacc[jt][i] = e; sm[i] += e; }
#pragma unroll
            for (int o = 1; o < 16; o <<= 1)
#pragma unroll
                for (int i = 0; i < 4; ++i) sm[i] += __shfl_xor(sm[i], o);
            f32x4 inv;
#pragma unroll
            for (int i = 0; i < 4; ++i) inv[i] = 1.f / sm[i];
            if (fq == 0) {
#pragma unroll
                for (int jt = 0; jt < 16; ++jt) *(f32x4*)(Pl + ((size_t)wid * 256 + 16 * jt + fr) * 4) = sacc[jt] * inv;
            }
            asm volatile("s_waitcnt lgkmcnt(0)" ::: "memory");
            const int r8 = lane >> 3, c8 = lane & 7;
            const unsigned char* vbase8 = (const unsigned char*)(PROJ + O_VG) + (size_t)(b * 2 + g) * SEQ * 128 + 16 * c8;
            f32x2 oa2[4][8];
#pragma unroll
            for (int h = 0; h < 4; ++h)
#pragma unroll
                for (int d = 0; d < 8; ++d) oa2[h][d] = (f32x2){0.f, 0.f};
            for (int s0 = 0; s0 < nsel; s0 += 128) {
                uint4 vv[16];
#pragma unroll
                for (int e = 0; e < 16; ++e) { const int slot = s0 + 8 * e + r8; const int idx = (int)sel[qq * 256 + (slot < nsel ? slot : nsel - 1)];
                    vv[e] = *(const uint4*)(vbase8 + (size_t)idx * 128); }
                __builtin_amdgcn_sched_barrier(0);
#pragma unroll
                for (int e = 0; e < 16; ++e) { const int slot = s0 + 8 * e + r8;
                    if ((e & 3) == 0) __builtin_amdgcn_sched_barrier(0);
                    const f32x4 pp = *(const f32x4*)(Pl + ((size_t)wid * 256 + slot) * 4);
                    const f32x2 p0 = (f32x2){pp.x, pp.x}, p1 = (f32x2){pp.y, pp.y}, p2 = (f32x2){pp.z, pp.z}, p3 = (f32x2){pp.w, pp.w};
                    const unsigned wds[4] = {vv[e].x, vv[e].y, vv[e].z, vv[e].w};
#pragma unroll
                    for (int w = 0; w < 4; ++w) {
                        const f32x2 lo = __builtin_amdgcn_cvt_pk_f32_fp8((int)wds[w], false), hi = __builtin_amdgcn_cvt_pk_f32_fp8((int)wds[w], true);
                        oa2[0][2 * w] = __builtin_elementwise_fma(lo, p0, oa2[0][2 * w]); oa2[0][2 * w + 1] = __builtin_elementwise_fma(hi, p0, oa2[0][2 * w + 1]);
                        oa2[1][2 * w] = __builtin_elementwise_fma(lo, p1, oa2[1][2 * w]); oa2[1][2 * w + 1] = __builtin_elementwise_fma(hi, p1, oa2[1][2 * w + 1]);
                        oa2[2][2 * w] = __builtin_elementwise_fma(lo, p2, oa2[2][2 * w]); oa2[2][2 * w + 1] = __builtin_elementwise_fma(hi, p2, oa2[2][2 * w + 1]);
                        oa2[3][2 * w] = __builtin_elementwise_fma(lo, p3, oa2[3][2 * w]); oa2[3][2 * w + 1] = __builtin_elementwise_fma(hi, p3, oa2[3][2 * w + 1]); }
                }
            }
#pragma unroll
            for (int h = 0; h < 4; ++h)
#pragma unroll
                for (int d = 0; d < 8; ++d) { f32x2 v = oa2[h][d];
                    v.x += __shfl_xor(v.x, 8); v.y += __shfl_xor(v.y, 8); v.x += __shfl_xor(v.x, 16); v.y += __shfl_xor(v.y, 16); v.x += __shfl_xor(v.x, 32); v.y += __shfl_xor(v.y, 32); oa2[h][d] = v; }
            if (r8 == 0) {
                h16* orow = MIXA + (size_t)tokq * DM + (g * 4) * 128 + 16 * c8;
#pragma unroll
                for (int h = 0; h < 4; ++h) { h16x8 w0, w1;
#pragma unroll
                    for (int d = 0; d < 4; ++d) { w0[2 * d] = (h16)oa2[h][d].x; w0[2 * d + 1] = (h16)oa2[h][d].y; w1[2 * d] = (h16)oa2[h][4 + d].x; w1[2 * d + 1] = (h16)oa2[h][4 + d].y; }
                    *(h16x8*)(orow + h * 128) = w0; *(h16x8*)(orow + h * 128 + 8) = w1; }
            }
            asm volatile("s_waitcnt lgkmcnt(0)" ::: "memory");
        }
    }
}

__device__ __forceinline__ Gemm mk_gemm(const h16* A, int lda, const h16* Bt, int ldb, int M, int N, int K, int nB = 1, size_t sA = 0, size_t sB = 0) {
    Gemm g; g.A = A; g.Bt = Bt; g.lda = lda; g.ldb = ldb; g.nM = M / 256; g.nN = N / 256; g.nB = nB; g.K = K; g.strideA = sA; g.strideB = sB; return g;
}

__device__ __forceinline__ int opaque(int v) { asm volatile("" : "+v"(v)); return v; }
enum { K_FUP0 = 0, K_FDN0, K_LN0, K_MIE, K_S5A, K_CARRY, K_S5B, K_GLU, K_MO, K_LN1, K_FUP1, K_FDN1, K_LN2, K_PLE, K_MIO, K_DSA };
constexpr unsigned long long tbl_even() { const int k[14] = {K_FUP0, K_FDN0, K_LN0, K_MIE, K_S5A, K_CARRY, K_S5B, K_GLU, K_MO, K_LN1, K_FUP1, K_FDN1, K_LN2, K_PLE}; unsigned long long r = 0; for (int i = 0; i < 14; ++i) r |= (unsigned long long)k[i] << (4 * i); return r; }
constexpr unsigned long long tbl_odd() { const int k[12] = {K_FUP0, K_FDN0, K_LN0, K_MIO, K_DSA, K_CARRY  , K_MO, K_LN1, K_FUP1, K_FDN1, K_LN2, K_PLE}; unsigned long long r = 0; for (int i = 0; i < 12; ++i) r |= (unsigned long long)k[i] << (4 * i); return r; }

__global__ void __launch_bounds__(512, 2) fwd_megakernel(Params P) {
    extern __shared__ __attribute__((aligned(16))) unsigned char shm[];
    cg::grid_group grid = cg::this_grid();
    LAS unsigned char* lds = (LAS unsigned char*)shm;
    volatile LAS unsigned* xbst = (volatile LAS unsigned*)(lds + LDS_BYTES - 16);
    if (threadIdx.x == 0) { const unsigned x_ = xb_xcc_id(); xbst[0] = 0u; xbst[1] = 0u; xbst[2] = xb_add(&((unsigned*)(P.ws + OFF_BAR))[XB_XCNT(x_)], 1u); xbst[3] = x_; }
    __syncthreads();

    if (blockIdx.x < 64) s5_build(P, blockIdx.x >> 5, blockIdx.x & 31, (float*)shm);
    prep_transposes(P, (float*)shm);
    cvt_pass(P.x, (h16*)(P.ws + OFF_MIXA), (size_t)NTOK * DM, nullptr);
    grid.sync();

    for (int i = 0; i < DEPTH; ++i) {
        const bool even = (i & 1) == 0; const int nst = even ? 14 : 12; const unsigned long long tbl = even ? tbl_even() : tbl_odd();
        for (int st = 0; st < nst; ++st) {
            const int kind = (int)((tbl >> (4 * st)) & 15ull), j = i >> 1;
            unsigned long long ka_ = (unsigned long long)__builtin_amdgcn_kernarg_segment_ptr(); asm volatile("" : "+s"(ka_));
            const __attribute__((address_space(4))) Params* PK = (const __attribute__((address_space(4))) Params*)ka_;
            unsigned char* ws = PK->ws;
            float* H = PK->out;
            h16* H16 = (h16*)(ws + OFF_H16);
            h16* MIXA = (h16*)(ws + OFF_MIXA);
            h16* R1 = (h16*)(ws + OFF_R1);
            h16* UG = (h16*)(ws + OFF_R1 + R1_UG);
            float* SLOC = (float*)(ws + OFF_R1 + R1_SLOC);
            h16* Z = (h16*)(ws + OFF_R1 + R1_Z);
            h16* P16 = (h16*)(ws + OFF_P16);
            EpiArgs E{};
            switch (kind) {
            case K_FUP0: case K_FUP1: {
                const int li = i * 2 + (kind == K_FUP1 ? 1 : 0);
                E.h0 = R1;
                gemm_phase<E_SWIGLU>(lds, mk_gemm(kind == K_FUP0 ? MIXA : H16, DM, (const h16*)(ws + OFF_W13 + li * SZ_W13), DM, NTOK, 5632, DM), E);
            } break;
            case K_FDN0: case K_FDN1: case K_MO: {
                E.ch0 = (kind == K_FDN0) ? MIXA : H16; E.h0 = H16;
                if (kind == K_MO) { E.s0 = 1.f;
                    gemm_phase<E_RES>(lds, mk_gemm(MIXA, DM, (const h16*)(ws + (even ? OFF_ABOUT : OFF_COUT) + j * SZ_SQ), DM, NTOK, DM, DM), E);
                } else { const int li = i * 2 + (kind == K_FDN1 ? 1 : 0); E.s0 = 0.5f;
                    gemm_phase<E_RES>(lds, mk_gemm(R1, DFF, (const h16*)(ws + OFF_W2T + li * SZ_W2T), DFF, NTOK, DM, DFF), E); }
            } break;
            case K_LN0: case K_LN1: case K_LN2: {
                const int idx = i * 3 + (kind == K_LN0 ? 0 : (kind == K_LN1 ? 1 : 2));
                ln_pass(H16, PK->ln_g + (size_t)idx * DM, PK->ln_b + (size_t)idx * DM);
                if (kind == K_LN1) cvt_pass(PK->p + (size_t)i * NTOK * 256, P16, (size_t)NTOK * 256, nullptr);
                if (kind == K_LN2) { E.h0 = R1;
                    gemm_phase<E_PP>(lds, mk_gemm(P16, 256, (const h16*)(ws + OFF_WPT + i * SZ_WPT), 256, NTOK, DM, 256), E); }
            } break;
            case K_MIE: {
                E.h0 = R1; E.h1 = UG;
                gemm_phase<E_PROJ_EVEN>(lds, mk_gemm(H16, DM, (const h16*)(ws + OFF_ABIN + j * SZ_ABIN), DM, NTOK, 2048, DM), E);
            } break;
            case K_S5A: {
                E.f0 = SLOC;
                gemm_phase<E_S5A>(lds, mk_gemm(UG, 640, (const h16*)(ws + OFF_W1M + j * SZ_W1M), 512, 1024, 256, 512, 32, (size_t)1024 * 640, (size_t)256 * 512), E);
                conv_pass(R1, PK->convw + (size_t)j * 1536, MIXA);
            } break;
            case K_CARRY:
                if (even) carry_pass(SLOC, UG, (const float*)(ws + OFF_A32) + (size_t)j * 32 * 64 * 2);
                else dsa_attend(R1, (const unsigned short*)(ws + OFF_R1 + R1_IDX), (const int*)(ws + OFF_R1 + R1_CNT), MIXA, shm, (unsigned*)(ws + OFF_BAR), xbst[3], xbst[2]);
                break;
            case K_S5B: {
                E.ch0 = UG; E.cf0 = PK->s5d + (size_t)j * 512; E.h0 = Z;
                gemm_phase<E_S5B>(lds, mk_gemm(UG, 640, (const h16*)(ws + OFF_M2 + j * SZ_M2), 640, 1024, 512, 640, 32, (size_t)1024 * 640, (size_t)512 * 640), E);
            } break;
            case K_GLU: {
                E.ch0 = Z; E.cf0 = PK->bglu + (size_t)j * 512; E.h0 = MIXA;
                gemm_phase<E_GLU>(lds, mk_gemm(Z, 512, (const h16*)(ws + OFF_WGLU + j * SZ_WGLU), 512, NTOK, 512, 512), E);
            } break;
            case K_MIO: {
                E.h0 = R1; E.pos = PK->pos;
                gemm_phase<E_PROJ_ODD>(lds, mk_gemm(H16, DM, (const h16*)(ws + OFF_CIN + j * SZ_CIN), DM, NTOK, 2304, DM), E);
            } break;
            case K_DSA: dsa_select(R1, (unsigned short*)(ws + OFF_R1 + R1_IDX), (int*)(ws + OFF_R1 + R1_CNT), shm, (unsigned*)(ws + OFF_BAR), xbst[3], xbst[2]); break;
            case K_PLE: {
                E.f0 = (i == DEPTH - 1) ? H : nullptr; E.ch0 = R1; E.ch1 = H16; E.h0 = MIXA;
                gemm_phase<E_PLE>(lds, mk_gemm(H16, DM, (const h16*)(ws + OFF_WGT + i * SZ_SQ), DM, NTOK, DM, DM), E);
            } break;
            }
            xcd_barrier((unsigned*)(ws + OFF_BAR), xbst);
        }
    }
}

extern "C" void kernel_launch(void* const* d_in, const int* in_sizes, int n_in, void* d_out, int out_size, void* d_ws, size_t ws_size, hipStream_t stream) {
    static int grid_blocks = 0;
    if (grid_blocks == 0) {
        if (n_in != 25 || out_size != NTOK * DM || ws_size < WS_END) { fprintf(stderr, "kernel_launch: unexpected shapes (n_in %d, out %d, ws %zu, need %zu)\n", n_in, out_size, ws_size, (size_t)WS_END); grid_blocks = -1; return; }
        int dev = 0, cus = 0, per_cu = 0;
        hipGetDevice(&dev);
        hipDeviceGetAttribute(&cus, hipDeviceAttributeMultiprocessorCount, dev);
        if (hipFuncSetAttribute((const void*)fwd_megakernel, hipFuncAttributeMaxDynamicSharedMemorySize, LDS_BYTES) != hipSuccess) { fprintf(stderr, "kernel_launch: hipFuncSetAttribute failed\n"); grid_blocks = -1; return; }
        if (hipOccupancyMaxActiveBlocksPerMultiprocessor(&per_cu, (const void*)fwd_megakernel, 512, LDS_BYTES) != hipSuccess || per_cu < 1) { fprintf(stderr, "kernel_launch: occupancy query says %d\n", per_cu); per_cu = 1; }
        (void)hipGetLastError();
        grid_blocks = cus * per_cu;
    }
    if (grid_blocks < 0) return;
    Params p{};
    p.x = (const float*)d_in[0]; p.p = (const float*)d_in[1]; p.pos = (const int*)d_in[2];
    p.ln_g = (const float*)d_in[3]; p.ln_b = (const float*)d_in[4]; p.w1 = (const float*)d_in[5]; p.w3 = (const float*)d_in[6]; p.w2 = (const float*)d_in[7];
    p.plep = (const float*)d_in[8]; p.pleg = (const float*)d_in[9]; p.abin = (const float*)d_in[10]; p.about = (const float*)d_in[11]; p.convw = (const float*)d_in[12];
    p.lamre = (const float*)d_in[13]; p.lamim = (const float*)d_in[14]; p.logdt = (const float*)d_in[15]; p.bre = (const float*)d_in[16]; p.bim = (const float*)d_in[17];
    p.cre = (const float*)d_in[18]; p.cim = (const float*)d_in[19]; p.s5d = (const float*)d_in[20]; p.wglu = (const float*)d_in[21]; p.bglu = (const float*)d_in[22];
    p.cin = (const float*)d_in[23]; p.cout = (const float*)d_in[24];
    p.out = (float*)d_out; p.ws = (unsigned char*)d_ws;
    if (hipMemsetAsync((char*)d_ws + OFF_BAR, 0, 16384, stream) != hipSuccess) { fprintf(stderr, "kernel_launch: memset of barrier words failed\n"); return; }
    void* args[] = {&p};
    hipError_t e = hipLaunchCooperativeKernel((const void*)fwd_megakernel, dim3(grid_blocks), dim3(512), args, LDS_BYTES, stream);
    if (e != hipSuccess) fprintf(stderr, "cooperative launch failed: %s (grid %d)\n", hipGetErrorString(e), grid_blocks);
}
```

```cpp
#include <hip/hip_runtime.h>
#include <hip/hip_cooperative_groups.h>
#include <cstdio>
namespace cg = cooperative_groups;

#define LAS __attribute__((address_space(3)))
typedef _Float16 h16;
typedef _Float16 h16x8 __attribute__((ext_vector_type(8)));
typedef _Float16 h16x4 __attribute__((ext_vector_type(4)));
typedef _Float16 h16x2 __attribute__((ext_vector_type(2)));
typedef float f32x4 __attribute__((ext_vector_type(4)));
typedef float f32x2 __attribute__((ext_vector_type(2)));

constexpr int NTOK = 32768, DM = 1024, DFF = 2816, SEQ = 8192, NBATCH = 4, DEPTH = 4;
constexpr float DN_ALPHA = 1.6817928305074292f;
constexpr float LN_EPS = 1e-5f;
constexpr int LDS_BYTES = 147456;

constexpr size_t SZ_W13 = (size_t)5632 * 1024 * 2, SZ_W2T = (size_t)1024 * 2816 * 2, SZ_WPT = (size_t)1024 * 256 * 2, SZ_SQ = (size_t)1024 * 1024 * 2;
constexpr size_t SZ_ABIN = (size_t)2048 * 1024 * 2, SZ_WGLU = (size_t)512 * 512 * 2, SZ_CIN = (size_t)2304 * 1024 * 2;
constexpr size_t SZ_W1M = (size_t)32 * 256 * 512 * 2, SZ_M2 = (size_t)32 * 512 * 640 * 2;
constexpr size_t OFF_W13 = 0;
constexpr size_t OFF_W2T = OFF_W13 + 8 * SZ_W13;
constexpr size_t OFF_WPT = OFF_W2T + 8 * SZ_W2T;
constexpr size_t OFF_WGT = OFF_WPT + 4 * SZ_WPT;
constexpr size_t OFF_ABIN = OFF_WGT + 4 * SZ_SQ;
constexpr size_t OFF_ABOUT = OFF_ABIN + 2 * SZ_ABIN;
constexpr size_t OFF_WGLU = OFF_ABOUT + 2 * SZ_SQ;
constexpr size_t OFF_CIN = OFF_WGLU + 2 * SZ_WGLU;
constexpr size_t OFF_COUT = OFF_CIN + 2 * SZ_CIN;
constexpr size_t OFF_W1M = OFF_COUT + 2 * SZ_SQ;
constexpr size_t OFF_M2 = OFF_W1M + 2 * SZ_W1M;
constexpr size_t OFF_A32 = OFF_M2 + 2 * SZ_M2;
constexpr size_t OFF_H16 = OFF_A32 + 65536;
constexpr size_t OFF_R1 = OFF_H16 + (size_t)NTOK * DM * 2;
constexpr size_t SZ_R1 = (size_t)201326592;
constexpr size_t OFF_MIXA = OFF_R1 + SZ_R1;
constexpr size_t OFF_P16 = OFF_MIXA + (size_t)NTOK * DM * 2;
constexpr size_t OFF_BAR = OFF_P16 + (size_t)NTOK * 256 * 2;
constexpr size_t WS_END = OFF_BAR + 16384;
constexpr size_t R1_UG = (size_t)NTOK * 1536 * 2;
constexpr size_t R1_SLOC = R1_UG + (size_t)32 * 1024 * 640 * 2;
constexpr size_t R1_Z = R1_SLOC + (size_t)32 * 1024 * 128 * 4;
static_assert(R1_Z + (size_t)NTOK * 512 * 2 <= SZ_R1, "R1 layout");
constexpr size_t O_Q = 0, O_KG = (size_t)NTOK * 1024, O_VG = O_KG + (size_t)NTOK * 256, O_QI = O_VG + (size_t)NTOK * 256, O_KI = O_QI + (size_t)NTOK * 512, O_WI = O_KI + (size_t)NTOK * 64;
constexpr size_t R1_IDX = (O_WI + (size_t)NTOK * 8) * 2;
constexpr size_t R1_CNT = R1_IDX + (size_t)NTOK * 256 * 2;
static_assert(R1_CNT + (size_t)NTOK * 4 <= SZ_R1, "R1 layout (odd)");

struct Params {
    const float* x; const float* p; const int* pos;
    const float *ln_g, *ln_b, *w1, *w3, *w2, *plep, *pleg, *abin, *about, *convw, *lamre, *lamim, *logdt, *bre, *bim, *cre, *cim, *s5d, *wglu, *bglu, *cin, *cout;
    float* out; unsigned char* ws;
};

__device__ __forceinline__ float sigmoidf_(float x) { return __builtin_amdgcn_rcpf(1.f + __expf(-x)); }
__device__ __forceinline__ float gelu_tanh(float x) { const float u = 0.7978845608028654f * (x + 0.044715f * x * x * x); return 0.5f * x * (2.f - 2.f * __builtin_amdgcn_rcpf(1.f + __expf(2.f * u))); }
__device__ __forceinline__ h16x4 cvt4(f32x4 v) { h16x4 r; r.x = (h16)v.x; r.y = (h16)v.y; r.z = (h16)v.z; r.w = (h16)v.w; return r; }
__device__ __forceinline__ float wave_sum(float v) {
#pragma unroll
    for (int o = 1; o < 64; o <<= 1) v += __shfl_xor(v, o);
    return v;
}
__device__ __forceinline__ void rope_sc(float pos, float inv, float& c, float& s) {
    const float ang = pos * inv;
    const double a = (double)ang;
    const double n = __builtin_rint(a * 0.15915494309189535);
    const float r = (float)(a - n * 6.283185307179586);
    s = __sinf(r); c = __cosf(r);
}

constexpr int BM = 256, BK = 64, HALF = 128, HTB = HALF * BK * 2, NXCD = 8, WGM = 8;
__device__ __forceinline__ int lds_byte(int r, int c) { const int st = (r >> 4) * 2 + (c >> 5), rr = r & 15, cc = c & 31, ob = rr * 64 + cc * 2; return st * 1024 + (ob ^ (((ob >> 9) & 1) << 5)); }
__device__ __forceinline__ void stage_rc(int b, int& R, int& C) { const int st = b / 1024, sb = b % 1024, swz = sb ^ (((sb >> 9) & 1) << 5); R = (st >> 1) * 16 + swz / 64; C = (st & 1) * 32 + (swz % 64) / 2; }

struct Unit { int pb, pm, pn; };
struct Gemm { const h16* A; const h16* Bt; int lda, ldb, nM, nN, nB, K; size_t strideA, strideB; };
struct EpiArgs { float* f0; const float* cf0; h16* h0; h16* h1; const h16* ch0; const h16* ch1; const int* pos; float s0; };

__device__ __forceinline__ bool unit_next(const Gemm& g, int i, Unit& u) {
    const int nwg = g.nM * g.nN; const long L = (long)i * gridDim.x + blockIdx.x; if (L >= (long)nwg * g.nB) return false;
    u.pb = (int)(L / nwg); int wgid = (int)(L % nwg);
    { const int q = nwg / NXCD, r = nwg % NXCD, xcd = wgid % NXCD, off = wgid / NXCD; wgid = (xcd < r ? xcd * (q + 1) : r * (q + 1) + (xcd - r) * q) + off; }
    const int nig = WGM * g.nN, gid = wgid / nig, fm = gid * WGM, gsz = (g.nM - fm) < WGM ? (g.nM - fm) : WGM;
    u.pm = fm + ((wgid % nig) % gsz); u.pn = (wgid % nig) / gsz; return true;
}

enum { E_SWIGLU = 0, E_RES = 1, E_PROJ_EVEN = 2, E_S5A = 3, E_S5B = 4, E_GLU = 5, E_PROJ_ODD = 6, E_PP = 7, E_PLE = 8 };

template <int MODE>
__device__ __forceinline__ void epilogue(const f32x4 (&acc)[2][2][4][2], const Unit& u, const EpiArgs& E, int wr, int wc, int fr, int fq) {
    const int row0 = u.pm * BM + wr * 64 + fr, tc0 = wc * 32 + 4 * fq;
    h16* obase = nullptr; int orstride = 0, obstride = 0;
    if constexpr (MODE == E_PROJ_ODD) {
        if (u.pn < 4) { obase = E.h0 + O_Q + u.pn * 256; orstride = 1024; obstride = 128; }
        else if (u.pn < 6) { obase = E.h0 + (u.pn == 4 ? O_KG : O_VG) + (size_t)((u.pm * BM) >> 13) * SEQ * 128; orstride = 128; obstride = SEQ * 128; }
        else if (u.pn < 8) { obase = E.h0 + O_QI + (u.pn - 6) * 256; orstride = 512; obstride = 128; }
        else { obase = E.h0 + O_KI; orstride = 64; obstride = 0; }
    }
#pragma unroll
    for (int ai = 0; ai < 2; ++ai)
#pragma unroll
        for (int m = 0; m < 4; ++m) {
            int row = row0 + ai * HALF + m * 16; asm volatile("" : "+v"(row));
            if constexpr (MODE == E_SWIGLU) {
#pragma unroll
                for (int bj = 0; bj < 2; ++bj) {
                    const f32x4 a = acc[ai][bj][m][0], b = acc[ai][bj][m][1]; f32x4 o;
#pragma unroll
                    for (int j = 0; j < 4; ++j) o[j] = a[j] * sigmoidf_(a[j]) * b[j];
                    const int hc = u.pn * 128 + bj * 64 + wc * 16 + 4 * fq;
                    *(h16x4*)(E.h0 + (size_t)row * DFF + hc) = cvt4(o);
                }
            } else if constexpr (MODE == E_PROJ_ODD) {
                const float pos = (float)E.pos[row];
                float cs[4], sn[4];
                const bool rot_a = (u.pn <= 4) && (wc == 0);
                const bool rot_i = (u.pn >= 6) && ((u.pn < 8) ? ((wc & 1) == 0) : (wc == 0));
                if (rot_a) {
#pragma unroll
                    for (int j = 0; j < 4; ++j) rope_sc(pos, exp2f(-(float)(4 * fq + j) * (18.931568569324174f / 16.f)), cs[j], sn[j]);
                } else if (rot_i) {
#pragma unroll
                    for (int j = 0; j < 4; ++j) rope_sc(pos, exp2f(-(float)((4 * fq + j) & 7) * (18.931568569324174f / 8.f)), cs[j], sn[j]);
                }
#pragma unroll
                for (int bj = 0; bj < 2; ++bj) {
                    f32x4 v0 = acc[ai][bj][m][0], v1 = acc[ai][bj][m][1];
                    if (rot_a) {
                        f32x4 t0, t1;
#pragma unroll
                        for (int j = 0; j < 4; ++j) { t0[j] = v0[j] * cs[j] - v1[j] * sn[j]; t1[j] = v1[j] * cs[j] + v0[j] * sn[j]; }
                        v0 = t0; v1 = t1;
                    }
                    if (u.pn >= 6) {
                        f32x4 y;
#pragma unroll
                        for (int j = 0; j < 4; ++j) y[j] = __shfl_xor(v0[j], 32);
                        if (rot_i && (u.pn < 8 || bj == 0)) {
#pragma unroll
                            for (int j = 0; j < 4; ++j) v0[j] = (fq < 2) ? (v0[j] * cs[j] - y[j] * sn[j]) : (v0[j] * cs[j] + y[j] * sn[j]);
                        }
                    }
                    if (u.pn == 4 || u.pn == 5) {
                        unsigned char* o8 = (unsigned char*)(E.h0 + (u.pn == 4 ? O_KG : O_VG)) + ((size_t)((row >> 13) * 2 + bj) * SEQ + (row & (SEQ - 1))) * 128 + tc0;
                        int w0 = __builtin_amdgcn_cvt_pk_fp8_f32(v0[0], v0[1], 0, false); w0 = __builtin_amdgcn_cvt_pk_fp8_f32(v0[2], v0[3], w0, true);
                        int w1 = __builtin_amdgcn_cvt_pk_fp8_f32(v1[0], v1[1], 0, false); w1 = __builtin_amdgcn_cvt_pk_fp8_f32(v1[2], v1[3], w1, true);
                        *(int*)o8 = w0; *(int*)(o8 + 16) = w1;
                    } else if (u.pn < 8 || (bj == 0 && wc < 2)) { h16* o = obase + (size_t)row * orstride + bj * obstride + tc0; *(h16x4*)o = cvt4(v0); *(h16x4*)(o + 16) = cvt4(v1); }
                    else if (bj == 0 && wc == 2 && fq < 2) *(h16x4*)(E.h0 + O_WI + (size_t)row * 8 + 4 * fq) = cvt4(v0);
                }
            } else if constexpr (MODE == E_RES || MODE == E_PLE || MODE == E_PP || MODE == E_GLU) {
#pragma unroll
                for (int bj = 0; bj < 2; ++bj) {
                    const int col = u.pn * 256 + bj * 128 + wc * 32 + 8 * fq;
                    const f32x4 v0 = acc[ai][bj][m][0], v1 = acc[ai][bj][m][1];
                    float vv[8] = {v0[0], v0[1], v0[2], v0[3], v1[0], v1[1], v1[2], v1[3]};
                    h16x8 o;
                    if constexpr (MODE == E_RES) {
                        const h16x8 hh = *(const h16x8*)(E.ch0 + (size_t)row * DM + col);
#pragma unroll
                        for (int j = 0; j < 8; ++j) o[j] = (h16)((float)hh[j] * DN_ALPHA + vv[j] * E.s0);
                        *(h16x8*)(E.h0 + (size_t)row * DM + col) = o;
                    } else if constexpr (MODE == E_GLU) {
                        const h16x8 zz = *(const h16x8*)(E.ch0 + (size_t)row * 512 + col); const f32x4 b0 = *(const f32x4*)(E.cf0 + col), b1 = *(const f32x4*)(E.cf0 + col + 4);
                        const float bb[8] = {b0[0], b0[1], b0[2], b0[3], b1[0], b1[1], b1[2], b1[3]};
#pragma unroll
                        for (int j = 0; j < 8; ++j) o[j] = (h16)((float)zz[j] * sigmoidf_(vv[j] + bb[j]));
                        *(h16x8*)(E.h0 + (size_t)row * DM + 512 + col) = o;
                    } else if constexpr (MODE == E_PP) {
#pragma unroll
                        for (int j = 0; j < 8; ++j) o[j] = (h16)vv[j];
                        *(h16x8*)(E.h0 + (size_t)row * DM + col) = o;
                    } else {
                        const h16x8 hh = *(const h16x8*)(E.ch1 + (size_t)row * DM + col); const h16x8 pp = *(const h16x8*)(E.ch0 + (size_t)row * DM + col); float of[8];
#pragma unroll
                        for (int j = 0; j < 8; ++j) { of[j] = (float)hh[j] + (float)pp[j] * sigmoidf_(vv[j]); o[j] = (h16)of[j]; }
                        if (E.f0) { *(f32x4*)(E.f0 + (size_t)row * DM + col) = (f32x4){of[0], of[1], of[2], of[3]}; *(f32x4*)(E.f0 + (size_t)row * DM + col + 4) = (f32x4){of[4], of[5], of[6], of[7]}; }
                        *(h16x8*)(E.h0 + (size_t)row * DM + col) = o;
                    }
                }
            } else {
#pragma unroll
                for (int bj = 0; bj < 2; ++bj)
#pragma unroll
                    for (int n = 0; n < 2; ++n) {
                        const int tc = bj * 128 + tc0 + n * 16, col = u.pn * 256 + tc;
                        const f32x4 v = acc[ai][bj][m][n];
                        if constexpr (MODE == E_RES) {
                            const h16x4 hh = *(const h16x4*)(E.ch0 + (size_t)row * DM + col); f32x4 y;
#pragma unroll
                            for (int j = 0; j < 4; ++j) y[j] = (float)hh[j] * DN_ALPHA + v[j] * E.s0;
                            *(h16x4*)(E.h0 + (size_t)row * DM + col) = cvt4(y);
                        } else if constexpr (MODE == E_PROJ_EVEN) {
                            if (u.pn < 6) *(h16x4*)(E.h0 + (size_t)row * 1536 + col) = cvt4(v);
                            else { const int ch = col - 1536, g = ch >> 4, ci = ch & 15;
                                *(h16x4*)(E.h1 + ((size_t)g * 1024 + (row >> 5)) * 640 + (row & 31) * 16 + ci) = cvt4(v); }
                        } else if constexpr (MODE == E_S5A) {
                            if (bj == 0) *(f32x4*)(E.f0 + ((size_t)u.pb * 1024 + row) * 128 + tc) = v * (1.f / 1024.f);
                        } else if constexpr (MODE == E_S5B) {
                            const int t = col >> 4, co = col & 15, ch = u.pb * 16 + co;
                            const h16x4 uu = *(const h16x4*)(E.ch0 + ((size_t)u.pb * 1024 + row) * 640 + col);
                            const f32x4 d = *(const f32x4*)(E.cf0 + ch); f32x4 z;
#pragma unroll
                            for (int j = 0; j < 4; ++j) z[j] = gelu_tanh(v[j] * (1.f / 1024.f) + d[j] * (float)uu[j]);
                            *(h16x4*)(E.h0 + ((size_t)row * 32 + t) * 512 + ch) = cvt4(z);
                        } else if constexpr (MODE == E_GLU) {
                            const h16x4 zz = *(const h16x4*)(E.ch0 + (size_t)row * 512 + col); const f32x4 bb = *(const f32x4*)(E.cf0 + col); f32x4 o;
#pragma unroll
                            for (int j = 0; j < 4; ++j) o[j] = (float)zz[j] * sigmoidf_(v[j] + bb[j]);
                            *(h16x4*)(E.h0 + (size_t)row * DM + 512 + col) = cvt4(o);
                        } else if constexpr (MODE == E_PP) {
                            *(h16x4*)(E.h0 + (size_t)row * DM + col) = cvt4(v);
                        } else if constexpr (MODE == E_PLE) {
                            const h16x4 hh = *(const h16x4*)(E.ch1 + (size_t)row * DM + col); const h16x4 pp = *(const h16x4*)(E.ch0 + (size_t)row * DM + col); f32x4 o;
#pragma unroll
                            for (int j = 0; j < 4; ++j) o[j] = (float)hh[j] + (float)pp[j] * sigmoidf_(v[j]);
                            if (E.f0) *(f32x4*)(E.f0 + (size_t)row * DM + col) = o;
                            *(h16x4*)(E.h0 + (size_t)row * DM + col) = cvt4(o);
                        }
                    }
            }
            __builtin_amdgcn_sched_barrier(0);
        }
}

template <int MODE>
__device__ __forceinline__ void gemm_phase(LAS unsigned char* lds, const Gemm g, const EpiArgs E) {
    int tid_ = threadIdx.x; asm volatile("" : "+v"(tid_));
    const int tid = tid_, wid = __builtin_amdgcn_readfirstlane(tid >> 6), lane = tid & 63, wr = wid >> 2, wc = wid & 3, fr = lane & 15, fq = lane >> 4;
    const int K = g.K, nt = K / BK;
    unsigned voffA[2], voffB[2];
    constexpr bool PERM = (MODE == E_RES || MODE == E_PLE || MODE == E_PP || MODE == E_GLU);
#pragma unroll
    for (int i = 0; i < 2; ++i) { int R, C; stage_rc(tid * 16 + i * 8192, R, C);
        int Rb = R; if (PERM) { const int rho = R & 31, nn = rho >> 4, ii = rho & 15; Rb = (R & ~31) + 8 * (ii >> 2) + 4 * nn + (ii & 3); }
        voffA[i] = (unsigned)(R * g.lda + C) * 2u; voffB[i] = (unsigned)(Rb * g.ldb + C) * 2u; }
    const size_t kstep = (size_t)(BK * 2);
    const size_t hstepA = (size_t)HALF * g.lda * 2, hstepB = (size_t)HALF * g.ldb * 2;
    const unsigned ldsw = (unsigned)wid * 1024u;
    const int aoff = lds_byte(wr * 64 + fr, fq * 8), boff = lds_byte(wc * 32 + fr, fq * 8);
#define G_SA(b, h) (((b) * 2 + (h)) * HTB)
#define G_SB(b, h) ((4 + (b) * 2 + (h)) * HTB)
#define G_STAGE(bufoff, gbase, voff) do { _Pragma("unroll") for (int _i = 0; _i < 2; ++_i) \
        __builtin_amdgcn_global_load_lds((const unsigned*)((const char*)(gbase) + (voff)[_i]), (LAS unsigned*)(lds + (bufoff) + ldsw + _i * 8192), 16, 0, 0); } while (0)
#define G_LDA(dst, b, h) do { _Pragma("unroll") for (int m = 0; m < 4; ++m) _Pragma("unroll") for (int k = 0; k < 2; ++k) dst[m][k] = *(const LAS h16x8*)(lds + G_SA(b, h) + aoff + m * 2048 + k * 1024); } while (0)
#define G_LDB(dst, b, h) do { _Pragma("unroll") for (int n = 0; n < 2; ++n) _Pragma("unroll") for (int k = 0; k < 2; ++k) dst[n][k] = *(const LAS h16x8*)(lds + G_SB(b, h) + boff + n * 2048 + k * 1024); } while (0)
#define G_MMA(ai, bj, At, Bt) do { __builtin_amdgcn_s_setprio(1); _Pragma("unroll") for (int m = 0; m < 4; ++m) _Pragma("unroll") for (int n = 0; n < 2; ++n) _Pragma("unroll") for (int k = 0; k < 2; ++k) \
        acc[ai][bj][m][n] = __builtin_amdgcn_mfma_f32_16x16x32_f16(Bt[n][k], At[m][k], acc[ai][bj][m][n], 0, 0, 0); __builtin_amdgcn_s_setprio(0); } while (0)
#define G_WAIT_V(n) asm volatile("s_waitcnt vmcnt(" #n ")" ::: "memory")
#define G_WAIT_L(n) asm volatile("s_waitcnt lgkmcnt(" #n ")" ::: "memory")
#define G_BAR __builtin_amdgcn_s_barrier()
#define G_SCHED __builtin_amdgcn_sched_barrier(0)
    Unit cur, nxt; int ui = 0;
    if (!unit_next(g, 0, cur)) return;
    f32x4 acc[2][2][4][2];
#pragma unroll
    for (int a = 0; a < 2; ++a)
#pragma unroll
        for (int b = 0; b < 2; ++b)
#pragma unroll
            for (int m = 0; m < 4; ++m)
#pragma unroll
                for (int n = 0; n < 2; ++n) acc[a][b][m][n] = (f32x4){0.f, 0.f, 0.f, 0.f};
    h16x8 At[4][2], B0[2][2], B1[2][2];
    const char* cA = (const char*)(g.A + (size_t)cur.pb * g.strideA) + (size_t)cur.pm * 2 * hstepA;
    const char* cB = (const char*)(g.Bt + (size_t)cur.pb * g.strideB) + (size_t)cur.pn * 2 * hstepB;
    G_STAGE(G_SB(0, 0), cB, voffB); G_STAGE(G_SA(0, 0), cA, voffA); G_STAGE(G_SB(0, 1), cB + hstepB, voffB); G_STAGE(G_SA(0, 1), cA + hstepA, voffA);
    if (wr == 1) G_BAR;
    G_WAIT_V(4); G_BAR;
    G_STAGE(G_SB(1, 0), cB + kstep, voffB); G_STAGE(G_SA(1, 0), cA + kstep, voffA); G_STAGE(G_SB(1, 1), cB + hstepB + kstep, voffB);
    G_WAIT_V(6); G_BAR;
    for (;;) {
        const bool has_next = unit_next(g, ui + 1, nxt);
        const char* nA = has_next ? (const char*)(g.A + (size_t)nxt.pb * g.strideA) + (size_t)nxt.pm * 2 * hstepA : cA;
        const char* nB = has_next ? (const char*)(g.Bt + (size_t)nxt.pb * g.strideB) + (size_t)nxt.pn * 2 * hstepB : cB;
        for (int t = 0; t < nt; t += 2) {
            const bool last = (t == nt - 2);
            const char* a1 = cA + (size_t)(t + 1) * kstep;
            const char* a2 = last ? nA : cA + (size_t)(t + 2) * kstep; const char* b2 = last ? nB : cB + (size_t)(t + 2) * kstep;
            const char* a3 = a2 + kstep; const char* b3 = b2 + kstep;
            G_LDB(B0, 0, 0); G_SCHED; G_LDA(At, 0, 0); G_STAGE(G_SA(1, 1), a1 + hstepA, voffA);
            G_WAIT_L(8); G_BAR; G_WAIT_L(0); G_MMA(0, 0, At, B0); G_BAR; G_SCHED;
            G_LDB(B1, 0, 1); G_STAGE(G_SB(0, 0), b2, voffB);
            G_BAR; G_WAIT_L(0); G_MMA(0, 1, At, B1); G_BAR;
            G_LDA(At, 0, 1); G_STAGE(G_SA(0, 0), a2, voffA);
            G_BAR; G_WAIT_L(0); G_MMA(1, 0, At, B0); G_BAR; G_SCHED;
            G_STAGE(G_SB(0, 1), b2 + hstepB, voffB);
            G_WAIT_V(6); G_BAR; G_MMA(1, 1, At, B1); G_BAR;
            G_LDB(B0, 1, 0); G_SCHED; G_LDA(At, 1, 0); G_STAGE(G_SA(0, 1), a2 + hstepA, voffA);
            G_WAIT_L(8); G_BAR; G_WAIT_L(0); G_MMA(0, 0, At, B0); G_BAR; G_SCHED;
            G_LDB(B1, 1, 1); G_STAGE(G_SB(1, 0), b3, voffB);
            G_BAR; G_WAIT_L(0); G_MMA(0, 1, At, B1); G_BAR;
            G_LDA(At, 1, 1); G_STAGE(G_SA(1, 0), a3, voffA);
            G_BAR; G_WAIT_L(0); G_MMA(1, 0, At, B0); G_BAR; G_SCHED;
            G_STAGE(G_SB(1, 1), b3 + hstepB, voffB);
            G_WAIT_V(6); G_BAR; G_MMA(1, 1, At, B1); G_BAR;
        }
        epilogue<MODE>(acc, cur, E, wr, wc, fr, fq);
        if (!has_next) break;
#pragma unroll
        for (int a = 0; a < 2; ++a)
#pragma unroll
            for (int b = 0; b < 2; ++b)
#pragma unroll
                for (int m = 0; m < 4; ++m)
#pragma unroll
                    for (int n = 0; n < 2; ++n) acc[a][b][m][n] = (f32x4){0.f, 0.f, 0.f, 0.f};
        cur = nxt; cA = nA; cB = nB; ++ui;
    }
    G_WAIT_V(0);
    if (wr == 0) G_BAR;
    G_BAR;
#undef G_SA
#undef G_SB
#undef G_STAGE
#undef G_LDA
#undef G_LDB
#undef G_MMA
#undef G_WAIT_V
#undef G_WAIT_L
#undef G_BAR
#undef G_SCHED
}

__device__ __forceinline__ void tr_tile(const float* src, int N, int ldsrc, h16* dst, int lddst, int mode, int kb, int nb, float* scr) {
    const int t = threadIdx.x, k0 = kb * 64, n0 = nb * 64;
    { const int nl = t & 63, kl0 = t >> 6;
#pragma unroll
      for (int i = 0; i < 8; ++i) { const int kl = kl0 + 8 * i; scr[kl * 65 + nl] = (n0 + nl < N) ? src[(size_t)(k0 + kl) * ldsrc + n0 + nl] : 0.f; } }
    __syncthreads();
    { const int kp = t & 31, nl0 = t >> 5;
#pragma unroll
      for (int i = 0; i < 4; ++i) { const int nl = nl0 + 16 * i, n = n0 + nl;
          const int row = mode == 0 ? n : ((n >> 4) * 32 + (mode == 2 ? 16 : 0) + (n & 15));
          h16x2 v; v.x = (h16)scr[(2 * kp) * 65 + nl]; v.y = (h16)scr[(2 * kp + 1) * 65 + nl];
          *(h16x2*)(dst + (size_t)row * lddst + k0 + 2 * kp) = v; } }
    __syncthreads();
}

__device__ __forceinline__ void prep_transposes(const Params& P, float* scr) {
    unsigned char* ws = P.ws;
    constexpr int T_FFN = 704, N_FFN = 24 * T_FFN, T_PP = 64, T_SQ = 256, T_ABIN = 512, T_GLU = 64, T_CIN = 576;
    constexpr int TOTAL = N_FFN + 4 * T_PP + 4 * T_SQ + 2 * T_ABIN + 2 * T_SQ + 2 * T_GLU + 2 * T_CIN + 2 * T_SQ;
    constexpr int T1 = 12160;
    const int nb2 = (int)gridDim.x > 64 ? (int)gridDim.x - 64 : (int)gridDim.x;
    for (int it0 = blockIdx.x; ; ) {
        int it;
        if (it0 < T1) { it = it0; it0 += gridDim.x; if (it0 >= T1) it0 = (blockIdx.x >= 64 || gridDim.x <= 64) ? T1 + ((int)blockIdx.x >= 64 ? (int)blockIdx.x - 64 : (int)blockIdx.x) : TOTAL; }
        else { it = it0; it0 += nb2; }
        if (it >= TOTAL) break;
        int r = it;
        if (r < N_FFN) { const int mtx = r / T_FFN, tl = r % T_FFN, which = mtx / 8, li = mtx % 8;
            if (which == 0) tr_tile(P.w1 + (size_t)li * 1024 * 2816, 2816, 2816, (h16*)(ws + OFF_W13 + li * SZ_W13), 1024, 1, tl / 44, tl % 44, scr);
            else if (which == 1) tr_tile(P.w3 + (size_t)li * 1024 * 2816, 2816, 2816, (h16*)(ws + OFF_W13 + li * SZ_W13), 1024, 2, tl / 44, tl % 44, scr);
            else tr_tile(P.w2 + (size_t)li * 2816 * 1024, 1024, 1024, (h16*)(ws + OFF_W2T + li * SZ_W2T), 2816, 0, tl / 16, tl % 16, scr);
            continue; } r -= N_FFN;
        if (r < 4 * T_PP) { const int i = r / T_PP, tl = r % T_PP; tr_tile(P.plep + (size_t)i * 256 * 1024, 1024, 1024, (h16*)(ws + OFF_WPT + i * SZ_WPT), 256, 0, tl / 16, tl % 16, scr); continue; } r -= 4 * T_PP;
        if (r < 4 * T_SQ) { const int i = r / T_SQ, tl = r % T_SQ; tr_tile(P.pleg + (size_t)i * 1024 * 1024, 1024, 1024, (h16*)(ws + OFF_WGT + i * SZ_SQ), 1024, 0, tl / 16, tl % 16, scr); continue; } r -= 4 * T_SQ;
        if (r < 2 * T_ABIN) { const int i = r / T_ABIN, tl = r % T_ABIN; tr_tile(P.abin + (size_t)i * 1024 * 2048, 2048, 2048, (h16*)(ws + OFF_ABIN + i * SZ_ABIN), 1024, 0, tl / 32, tl % 32, scr); continue; } r -= 2 * T_ABIN;
        if (r < 2 * T_SQ) { const int i = r / T_SQ, tl = r % T_SQ; tr_tile(P.about + (size_t)i * 1024 * 1024, 1024, 1024, (h16*)(ws + OFF_ABOUT + i * SZ_SQ), 1024, 0, tl / 16, tl % 16, scr); continue; } r -= 2 * T_SQ;
        if (r < 2 * T_GLU) { const int i = r / T_GLU, tl = r % T_GLU; tr_tile(P.wglu + (size_t)i * 512 * 512, 512, 512, (h16*)(ws + OFF_WGLU + i * SZ_WGLU), 512, 0, tl / 8, tl % 8, scr); continue; } r -= 2 * T_GLU;
        if (r < 2 * T_CIN) { const int i = r / T_CIN, tl = r % T_CIN; tr_tile(P.cin + (size_t)i * 1024 * 2120, 2120, 2120, (h16*)(ws + OFF_CIN + i * SZ_CIN), 1024, 0, tl / 36, tl % 36, scr); continue; } r -= 2 * T_CIN;
        { const int i = r / T_SQ, tl = r % T_SQ; tr_tile(P.cout + (size_t)i * 1024 * 1024, 1024, 1024, (h16*)(ws + OFF_COUT + i * SZ_SQ), 1024, 0, tl / 16, tl % 16, scr); }
    }
}

__device__ __forceinline__ void s5_build(const Params& P, int j, int g, float* L) {
    float* abr = L;
    float* abi = L + 2112;
    float* bbr = L + 4224;
    float* bbi = L + 5248;
    float* ccr = L + 6272;
    float* cci = L + 7296;
    float* fre = L + 8320;
    float* fim = L + 8384;
    float* Kt = L + 8448;
    const int tid = threadIdx.x, jg = j * 32 + g;
    if (tid < 64) {
        const int p = tid;
        const float lr = fminf(P.lamre[jg * 64 + p], -1e-4f), li = P.lamim[jg * 64 + p], dt = expf(P.logdt[jg]);
        const float mag = expf(lr * dt), are = mag * cosf(li * dt), aim = mag * sinf(li * dt);
        const float nr = are - 1.f, ni = aim, den = lr * lr + li * li;
        fre[p] = (nr * lr + ni * li) / den; fim[p] = (ni * lr - nr * li) / den;
        float pr = 1.f, pi = 0.f;
        for (int d = 0; d <= 32; ++d) { abr[d * 64 + p] = pr; abi[d * 64 + p] = pi; const float t = pr * are - pi * aim; pi = pr * aim + pi * are; pr = t; }
    }
    __syncthreads();
    for (int e = tid; e < 1024; e += 512) {
        const int p = e >> 4;
        const float br = P.bre[(size_t)jg * 1024 + e], bi = P.bim[(size_t)jg * 1024 + e];
        bbr[e] = fre[p] * br - fim[p] * bi; bbi[e] = fre[p] * bi + fim[p] * br;
        ccr[e] = P.cre[(size_t)jg * 1024 + e]; cci[e] = P.cim[(size_t)jg * 1024 + e];
    }
    __syncthreads();
    for (int e = tid; e < 8192; e += 512) {
        const int d = e >> 8, co = (e >> 4) & 15, ci = e & 15; float s = 0.f;
        for (int p = 0; p < 64; ++p) {
            const float ar = abr[d * 64 + p], ai = abi[d * 64 + p], br = bbr[p * 16 + ci], bi = bbi[p * 16 + ci];
            const float wr_ = ar * br - ai * bi, wi_ = ar * bi + ai * br;
            s += ccr[co * 64 + p] * wr_ - cci[co * 64 + p] * wi_;
        }
        Kt[e] = s * 1024.f;
    }
    __syncthreads();
    h16* W1 = (h16*)(P.ws + OFF_W1M + (size_t)j * SZ_W1M) + (size_t)g * 256 * 512;
    for (int e = tid; e < 128 * 256; e += 512) {
        const int n = e >> 8, k = (e & 255) * 2, tau = k >> 4, ci = k & 15, p = n & 63, d = 31 - tau;
        const float ar = abr[d * 64 + p], ai = abi[d * 64 + p]; h16x2 v;
        if (n < 64) { v.x = (h16)(1024.f * (ar * bbr[p * 16 + ci] - ai * bbi[p * 16 + ci])); v.y = (h16)(1024.f * (ar * bbr[p * 16 + ci + 1] - ai * bbi[p * 16 + ci + 1])); }
        else { v.x = (h16)(1024.f * (ar * bbi[p * 16 + ci] + ai * bbr[p * 16 + ci])); v.y = (h16)(1024.f * (ar * bbi[p * 16 + ci + 1] + ai * bbr[p * 16 + ci + 1])); }
        *(h16x2*)(W1 + (size_t)n * 512 + k) = v;
        h16x2 z; z.x = (h16)0.f; z.y = (h16)0.f; *(h16x2*)(W1 + (size_t)(128 + n) * 512 + k) = z;
    }
    h16* M2 = (h16*)(P.ws + OFF_M2 + (size_t)j * SZ_M2) + (size_t)g * 512 * 640;
    for (int e = tid; e < 512 * 320; e += 512) {
        const int n = e / 320, k = (e % 320) * 2, t = n >> 4, co = n & 15; h16x2 v;
        if (k < 512) { const int tau = k >> 4, ci = k & 15;
            if (tau <= t) { v.x = (h16)Kt[(t - tau) * 256 + co * 16 + ci]; v.y = (h16)Kt[(t - tau) * 256 + co * 16 + ci + 1]; } else { v.x = (h16)0.f; v.y = (h16)0.f; } }
        else if (k < 576) { const int p = k - 512;
            v.x = (h16)(ccr[co * 64 + p] * abr[(t + 1) * 64 + p] - cci[co * 64 + p] * abi[(t + 1) * 64 + p]);
            v.y = (h16)(ccr[co * 64 + p + 1] * abr[(t + 1) * 64 + p + 1] - cci[co * 64 + p + 1] * abi[(t + 1) * 64 + p + 1]); }
        else { const int p = k - 576;
            v.x = (h16)(-(ccr[co * 64 + p] * abi[(t + 1) * 64 + p] + cci[co * 64 + p] * abr[(t + 1) * 64 + p]));
            v.y = (h16)(-(ccr[co * 64 + p + 1] * abi[(t + 1) * 64 + p + 1] + cci[co * 64 + p + 1] * abr[(t + 1) * 64 + p + 1])); }
        *(h16x2*)(M2 + (size_t)n * 640 + k) = v;
    }
    if (tid < 64) { f32x2 a; a.x = abr[32 * 64 + tid]; a.y = abi[32 * 64 + tid]; *(f32x2*)(P.ws + OFF_A32 + ((size_t)jg * 64 + tid) * 8) = a; }
    __syncthreads();
}

__device__ __forceinline__ void ln_pass(h16* Y16, const float* g, const float* b) {
    int tid_ = threadIdx.x; asm volatile("" : "+v"(tid_));
    const int lane = tid_ & 63, wave = tid_ >> 6;
    f32x4 gv[4], bv[4];
#pragma unroll
    for (int j = 0; j < 2; ++j)
#pragma unroll
        for (int q = 0; q < 2; ++q) { gv[2 * j + q] = *(const f32x4*)(g + 8 * lane + 512 * j + 4 * q); bv[2 * j + q] = *(const f32x4*)(b + 8 * lane + 512 * j + 4 * q); }
    for (int row0 = (blockIdx.x * 8 + wave) * 4; row0 < NTOK; row0 += gridDim.x * 32) {
        h16x8 w[4][2];
#pragma unroll
        for (int r = 0; r < 4; ++r)
#pragma unroll
            for (int j = 0; j < 2; ++j) w[r][j] = *(const h16x8*)(Y16 + (size_t)(row0 + r) * DM + 8 * lane + 512 * j);
#pragma unroll
        for (int r = 0; r < 4; ++r) {
            h16* yr = Y16 + (size_t)(row0 + r) * DM + 8 * lane; f32x4 v[4]; float s = 0.f;
#pragma unroll
            for (int j = 0; j < 2; ++j) {
                v[2 * j] = (f32x4){(float)w[r][j][0], (float)w[r][j][1], (float)w[r][j][2], (float)w[r][j][3]}; v[2 * j + 1] = (f32x4){(float)w[r][j][4], (float)w[r][j][5], (float)w[r][j][6], (float)w[r][j][7]}; }
#pragma unroll
            for (int j = 0; j < 4; ++j) s += (v[j].x + v[j].y) + (v[j].z + v[j].w);
            const float mean = wave_sum(s) * (1.f / DM); float s2 = 0.f;
#pragma unroll
            for (int j = 0; j < 4; ++j) { v[j] = v[j] - mean; s2 += (v[j].x * v[j].x + v[j].y * v[j].y) + (v[j].z * v[j].z + v[j].w * v[j].w); }
            const float rstd = 1.f / sqrtf(wave_sum(s2) * (1.f / DM) + LN_EPS);
#pragma unroll
            for (int j = 0; j < 2; ++j) { const f32x4 o0 = v[2 * j] * rstd * gv[2 * j] + bv[2 * j], o1 = v[2 * j + 1] * rstd * gv[2 * j + 1] + bv[2 * j + 1]; h16x8 o;
                o[0] = (h16)o0.x; o[1] = (h16)o0.y; o[2] = (h16)o0.z; o[3] = (h16)o0.w; o[4] = (h16)o1.x; o[5] = (h16)o1.y; o[6] = (h16)o1.z; o[7] = (h16)o1.w;
                *(h16x8*)(yr + 512 * j) = o; }
        }
    }
}

__device__ __forceinline__ void cvt_pass(const float* src, h16* dst, size_t n, float* dup) {
    for (size_t i = ((size_t)blockIdx.x * 512 + threadIdx.x) * 8; i < n; i += (size_t)gridDim.x * 512 * 8) {
        const f32x4 a = *(const f32x4*)(src + i), b = *(const f32x4*)(src + i + 4);
        h16x8 o; o[0] = (h16)a.x; o[1] = (h16)a.y; o[2] = (h16)a.z; o[3] = (h16)a.w; o[4] = (h16)b.x; o[5] = (h16)b.y; o[6] = (h16)b.z; o[7] = (h16)b.w;
        *(h16x8*)(dst + i) = o;
        if (dup) { *(f32x4*)(dup + i) = a; *(f32x4*)(dup + i + 4) = b; }
    }
}

__device__ __forceinline__ void conv_pass(const h16* PE, const float* cw, h16* MIXA) {
    for (size_t i = (size_t)blockIdx.x * 512 + threadIdx.x; i < (size_t)NTOK * 64; i += (size_t)gridDim.x * 512) {
        const int row = (int)(i >> 6), c = (int)(i & 63) * 8, l = row & (SEQ - 1);
        const h16* pr = PE + (size_t)row * 1536 + c;
        const h16x8 h0 = *(const h16x8*)pr, gb = *(const h16x8*)(pr + 512), g0 = *(const h16x8*)(pr + 1024);
        h16x8 h1, g1, h2, g2;
        if (l >= 1) { h1 = *(const h16x8*)(pr - 1536); g1 = *(const h16x8*)(pr - 1536 + 1024); }
        if (l >= 2) { h2 = *(const h16x8*)(pr - 3072); g2 = *(const h16x8*)(pr - 3072 + 1024); }
        h16x8 o;
#pragma unroll
        for (int e = 0; e < 8; ++e) {
            float v = cw[1024 + c + e] * ((float)g0[e] * (float)h0[e]);
            if (l >= 1) v += cw[512 + c + e] * ((float)g1[e] * (float)h1[e]);
            if (l >= 2) v += cw[c + e] * ((float)g2[e] * (float)h2[e]);
            o[e] = (h16)((float)gb[e] * v);
        }
        *(h16x8*)(MIXA + (size_t)row * DM + c) = o;
    }
}
__device__ __forceinline__ void carry_unit(const float* SLOC, h16* UG, const float* A32, unsigned char* shm, int b, int g) {
    int tid_ = threadIdx.x; asm volatile("" : "+v"(tid_));
    const int p = tid_ & 63, seg = tid_ >> 6;
    f32x2* segE = (f32x2*)shm;
    f32x2* segS = (f32x2*)(shm + 4096);
    const f32x2 a = *(const f32x2*)(A32 + ((size_t)g * 64 + p) * 2);
    const size_t row0 = (size_t)g * 1024 + b * 256 + seg * 32;
    float sr = 0.f, si = 0.f;
    for (int k0 = 0; k0 < 32; k0 += 4) {
        float xr[4], xi[4];
#pragma unroll
        for (int k = 0; k < 4; ++k) { xr[k] = SLOC[(row0 + k0 + k) * 128 + p]; xi[k] = SLOC[(row0 + k0 + k) * 128 + 64 + p]; }
#pragma unroll
        for (int k = 0; k < 4; ++k) { const float t = a.x * sr - a.y * si + xr[k]; si = a.x * si + a.y * sr + xi[k]; sr = t; }
    }
    { f32x2 e; e.x = sr; e.y = si; segE[seg * 64 + p] = e; }
    __syncthreads();
    if (seg == 0) {
        float mr = a.x, mi = a.y;
#pragma unroll
        for (int q = 0; q < 5; ++q) { const float t = mr * mr - mi * mi; mi = 2.f * mr * mi; mr = t; }
        float cr = 0.f, ci = 0.f;
#pragma unroll
        for (int s = 0; s < 8; ++s) { f32x2 st; st.x = cr; st.y = ci; segS[s * 64 + p] = st; const f32x2 e = segE[s * 64 + p];
            const float t = mr * cr - mi * ci + e.x; ci = mr * ci + mi * cr + e.y; cr = t; }
    }
    __syncthreads();
    { const f32x2 st = segS[seg * 64 + p]; sr = st.x; si = st.y; }
    for (int k0 = 0; k0 < 32; k0 += 4) {
        float xr[4], xi[4];
#pragma unroll
        for (int k = 0; k < 4; ++k) { xr[k] = SLOC[(row0 + k0 + k) * 128 + p]; xi[k] = SLOC[(row0 + k0 + k) * 128 + 64 + p]; }
#pragma unroll
        for (int k = 0; k < 4; ++k) {
            h16* ur = UG + (row0 + k0 + k) * 640 + 512 + p; ur[0] = (h16)(sr * 1024.f); ur[64] = (h16)(si * 1024.f);
            const float t = a.x * sr - a.y * si + xr[k]; si = a.x * si + a.y * sr + xi[k]; sr = t;
        }
    }
    __syncthreads();
}

#define XB_TMO      128
#define XB_XCNT(j)  (256  + 64 * (j))
#define XB_XSUB(j)  (1280 + 64 * (j))
#define XB_XGEN(j)  (2304 + 64 * (j))
#define XB_TOP      3328
#define XB_TOPGEN   3392
#define XCD_BAR_WORDS 3456
#define XB_SPIN_CAP (1u << 22)
__device__ __forceinline__ unsigned xb_ld(unsigned* p)              { return __hip_atomic_load(p, __ATOMIC_RELAXED, __HIP_MEMORY_SCOPE_AGENT); }
__device__ __forceinline__ unsigned xb_add(unsigned* p, unsigned v) { return __hip_atomic_fetch_add(p, v, __ATOMIC_RELAXED, __HIP_MEMORY_SCOPE_AGENT); }
__device__ __forceinline__ unsigned xb_xcc_id() { return (unsigned)__builtin_amdgcn_s_getreg((3 << 11) | 20) & 0xFu; }
#define XB_SPIN(cond, bar) do { unsigned _sp = 0; while (cond) { __builtin_amdgcn_s_sleep(1); \
    if ((++_sp & 255u) == 0u) { if (xb_ld(&(bar)[XB_TMO])) break; if (_sp > XB_SPIN_CAP) { atomicAdd(&(bar)[XB_TMO], 1u); break; } } } } while (0)
__device__ __forceinline__ void xcd_barrier_complete(unsigned* bar, unsigned x, unsigned& nloc, unsigned& nx) {
    const unsigned G = gridDim.x;
    unsigned sum, cnt, mine, sp = 0u;
    for (;;) {
        sum = 0u; cnt = 0u; mine = 0u;
#pragma unroll
        for (unsigned j = 0; j < 16; ++j) { const unsigned c = xb_ld(&bar[XB_XCNT(j)]); sum += c; cnt += (c > 0u) ? 1u : 0u; mine = (j == x) ? c : mine; }
        if (sum == G) break;
        __builtin_amdgcn_s_sleep(1);
        if ((++sp & 255u) == 0u) { if (xb_ld(&bar[XB_TMO])) break; if (sp > XB_SPIN_CAP) { atomicAdd(&bar[XB_TMO], 1u); break; } }
    }
    nloc = mine > 0u ? mine : 1u; nx = cnt > 0u ? cnt : 1u;
}
__device__ __forceinline__ void xcd_barrier(unsigned* bar, volatile LAS unsigned* st) {
    asm volatile("s_waitcnt vmcnt(0)" ::: "memory");
    __syncthreads();
    if (threadIdx.x == 0) {
        const unsigned x = xb_xcc_id();
        __builtin_amdgcn_s_waitcnt(0);
        unsigned nloc = st[0], nx = st[1];
        if (nloc == 0u) { xcd_barrier_complete(bar, x, nloc, nx); st[0] = nloc; st[1] = nx; }
        const unsigned old = xb_add(&bar[XB_XSUB(x)], 1u);
        const unsigned gen = old / nloc;
        if (old + 1u == (gen + 1u) * nloc) {
            __builtin_amdgcn_fence(__ATOMIC_RELEASE, "agent");
            asm volatile("s_waitcnt vmcnt(0)" ::: "memory");
            const unsigned og = xb_add(&bar[XB_TOP], 1u);
            const unsigned tg = og / nx;
            if (og + 1u == (tg + 1u) * nx) xb_add(&bar[XB_TOPGEN], 1u);
            else XB_SPIN(xb_ld(&bar[XB_TOPGEN]) == tg, bar);
            __builtin_amdgcn_fence(__ATOMIC_ACQUIRE, "agent");
            xb_add(&bar[XB_XGEN(x)], 1u);
            asm volatile("s_waitcnt vmcnt(0)" ::: "memory");
        } else {
            XB_SPIN(xb_ld(&bar[XB_XGEN(x)]) == gen, bar);
            __builtin_amdgcn_fence(__ATOMIC_ACQUIRE, "agent");
            asm volatile("s_waitcnt vmcnt(0)" ::: "memory");
        }
    }
    __syncthreads();
}

__device__ __forceinline__ bool xcd_unit_rank(unsigned* bar, unsigned x, unsigned r, int U, int u, int& rank, int& total) {
    unsigned c[16];
#pragma unroll
    for (int j = 0; j < 16; ++j) c[j] = xb_ld(&bar[XB_XCNT(j)]);
    int nx = 0, myo = 0;
#pragma unroll
    for (int j = 0; j < 16; ++j) if (c[j]) { if ((unsigned)j < x) ++myo; ++nx; }
    const int m = nx < U ? nx : U, um = u % m;
    if (myo % m != um) return false;
    int ord = 0; rank = (int)r; total = 0;
#pragma unroll
    for (int j = 0; j < 16; ++j) if (c[j]) { if (ord % m == um) { total += (int)c[j]; if ((unsigned)j < x) rank += (int)c[j]; } ++ord; }
    return true;
}

template <int PASS>
__device__ __forceinline__ void idx_tiles(const unsigned char* buf, int Tbase, int tq, int fr, int fq, const h16x8 (&aq)[2][2], const float (&wv)[8], const h16x2 (&wp)[4],
                                          unsigned* myhist, unsigned b0, unsigned* myctl, unsigned* mycand, unsigned short* out) {
    const int sw = (fr >> 1) & 7;
    const unsigned char* lp = buf + fr * 128;
#pragma unroll
    for (int hb = 0; hb < 2; ++hb) {
        h16x8 kf[8][2];
#pragma unroll
        for (int e = 0; e < 8; ++e) { const unsigned char* tp = lp + (hb * 8 + e) * 2048; kf[e][0] = *(const h16x8*)(tp + ((fq ^ sw) << 4)); kf[e][1] = *(const h16x8*)(tp + (((fq + 4) ^ sw) << 4)); }
#pragma unroll
        for (int e = 0; e < 8; ++e) { const int T = Tbase + hb * 8 + e;
            f32x4 a0 = (f32x4){0.f, 0.f, 0.f, 0.f}, a1 = a0;
            a0 = __builtin_amdgcn_mfma_f32_16x16x32_f16(aq[0][0], kf[e][0], a0, 0, 0, 0); a0 = __builtin_amdgcn_mfma_f32_16x16x32_f16(aq[0][1], kf[e][1], a0, 0, 0, 0);
            a1 = __builtin_amdgcn_mfma_f32_16x16x32_f16(aq[1][0], kf[e][0], a1, 0, 0, 0); a1 = __builtin_amdgcn_mfma_f32_16x16x32_f16(aq[1][1], kf[e][1], a1, 0, 0, 0);
            const h16x2 z2 = (h16x2){(h16)0.f, (h16)0.f};
            const h16x2 r0 = __builtin_elementwise_max(__builtin_bit_cast(h16x2, __builtin_amdgcn_cvt_pkrtz(a0[0], a0[1])), z2), r1 = __builtin_elementwise_max(__builtin_bit_cast(h16x2, __builtin_amdgcn_cvt_pkrtz(a0[2], a0[3])), z2);
            const h16x2 r2 = __builtin_elementwise_max(__builtin_bit_cast(h16x2, __builtin_amdgcn_cvt_pkrtz(a1[0], a1[1])), z2), r3 = __builtin_elementwise_max(__builtin_bit_cast(h16x2, __builtin_amdgcn_cvt_pkrtz(a1[2], a1[3])), z2);
            const float sa = __builtin_amdgcn_fdot2(r0, wp[0], __builtin_amdgcn_fdot2(r1, wp[1], __builtin_amdgcn_fdot2(r2, wp[2], __builtin_amdgcn_fdot2(r3, wp[3], 0.f, false), false), false), false);
            const int key = 16 * T + fr;
            if (key <= tq) {
                const unsigned bin = (unsigned)(int)fminf(fmaxf(sa * 32.f + 128.f, 0.f), 255.f);
                if (PASS == 1) { if (bin >= b0) atomicAdd(&myhist[fq * 256 + bin], 1u); }
                else {
                    if (bin > b0) { const unsigned pos = atomicAdd(&myctl[fq * 4 + 2], 1u); ((unsigned short*)myhist)[fq * 256 + (pos & 255u)] = (unsigned short)key; }
                    else if (bin == b0) { const unsigned c = atomicAdd(&myctl[fq * 4 + 3], 1u);
                        if (c < 128u) { float s = 0.f;
#pragma unroll
                            for (int r = 0; r < 4; ++r) s += wv[r] * fmaxf(a0[r], 0.f) + wv[4 + r] * fmaxf(a1[r], 0.f);
                            s = fminf(fmaxf(s, -3.99f), 3.99f);
                            mycand[(fq * 128 + c) * 2] = (unsigned)((s + 4.f) * 536870912.f); mycand[(fq * 128 + c) * 2 + 1] = (unsigned)key; } }
                }
            }
        }
        __builtin_amdgcn_sched_barrier(0);
    }
}
template <int PASS, bool SAMPLE>
__device__ __forceinline__ void idx_sweep(const h16* KIb, int nch, unsigned char* stage, int tid, int tq, int fr, int fq, const h16x8 (&aq)[2][2], const float (&wv)[8], const h16x2 (&wp)[4],
                                          unsigned* myhist, unsigned b0, unsigned* myctl, unsigned* mycand, unsigned short* out) {
    int loff[4];
#pragma unroll
    for (int i = 0; i < 4; ++i) { const int o = (tid + 512 * i) * 16, R = o >> 7, c16 = (o >> 4) & 7, r = R & 15; loff[i] = (R >> 4) * 2048 + r * 128 + ((c16 ^ ((r >> 1) & 7)) << 4); }
    const unsigned char* src = (const unsigned char*)KIb + tid * 16;
    h16x8 st[4];
    const int rot = (int)((blockIdx.x * 7u) % (unsigned)nch);
#pragma unroll
    for (int i = 0; i < 4; ++i) st[i] = *(const h16x8*)(src + (size_t)rot * 32768 + 8192 * i);
#pragma unroll
    for (int i = 0; i < 4; ++i) *(h16x8*)(stage + loff[i]) = st[i];
    __syncthreads();
    for (int c = 0; c < nch; ++c) {
        const bool more = (c + 1) < nch;
        int cc = c + rot; cc = cc >= nch ? cc - nch : cc;
        int cn = cc + 1; cn = cn >= nch ? 0 : cn;
        if (more) {
#pragma unroll
            for (int i = 0; i < 4; ++i) st[i] = *(const h16x8*)(src + (size_t)cn * 32768 + 8192 * i); }
        idx_tiles<PASS>(stage + (c & 1) * 32768, cc * 16, tq, fr, fq, aq, wv, wp, myhist, b0, myctl, mycand, out);
        if (PASS == 1 && SAMPLE && c == 1 && nch > 2) {
            asm volatile("s_waitcnt lgkmcnt(0)" ::: "memory");
            const unsigned want = (unsigned)((tq + 1) < 256 ? (tq + 1) : 256);
            unsigned cnt[16]; unsigned lsum = 0u;
#pragma unroll
            for (int i = 0; i < 16; ++i) { cnt[i] = myhist[fq * 256 + fr * 16 + i]; lsum += cnt[i]; }
            unsigned incl = lsum;
#pragma unroll
            for (int o = 1; o < 16; o <<= 1) { const unsigned v = __shfl_down(incl, o); if (fr + o < 16) incl += v; }
            const unsigned ns = __shfl(incl, fq * 16);
            const unsigned target = (unsigned)(2.f * (float)want * (float)ns / (float)(tq + 1)) + 10u;
            const unsigned above = incl - lsum;
            if (fr == 0) myctl[fq * 4] = 0u;
            asm volatile("s_waitcnt lgkmcnt(0)" ::: "memory");
            if (target < ns && above < target && target <= incl) { unsigned cum = above; int bin = 0; bool found = false;
#pragma unroll
                for (int i = 15; i >= 0; --i) { if (!found) { if (cum + cnt[i] >= target) { bin = i; found = true; } else cum += cnt[i]; } }
                myctl[fq * 4] = (unsigned)(fr * 16 + bin); }
            asm volatile("s_waitcnt lgkmcnt(0)" ::: "memory");
            const unsigned fb = myctl[fq * 4];
            b0 = fb > 0u ? fb - 1u : 0u;
            if (fr == 0) myctl[fq * 4 + 1] = b0;
        }
        if (more) {
#pragma unroll
            for (int i = 0; i < 4; ++i) *(h16x8*)(stage + ((c + 1) & 1) * 32768 + loff[i]) = st[i]; }
        __syncthreads();
    }
}

__device__ __forceinline__ void dsa_select(const h16* PROJ, unsigned short* IDX, int* CNT, unsigned char* shm, unsigned* bar, unsigned xcc, unsigned xrank) {
    int tid_ = threadIdx.x; asm volatile("" : "+v"(tid_));
    const int tid = tid_, wid = tid >> 6, lane = tid & 63, fr = lane & 15, fq = lane >> 4;
    unsigned char* stage = shm;
    unsigned* myhist = (unsigned*)(shm + 65536) + wid * 1024;
    unsigned* mycand = (unsigned*)(shm + 98304) + wid * 1024;
    unsigned* myctl = (unsigned*)(shm + 131072) + wid * 16;
    for (int b = 0; b < NBATCH; ++b) {
        int rank, total; if (!xcd_unit_rank(bar, xcc, xrank, NBATCH, b, rank, total)) continue;
        const int nrounds = (256 + total - 1) / total;
        const h16* KIb = PROJ + O_KI + (size_t)b * SEQ * 64;
        for (int k = 0; k < nrounds; ++k) {
            const int it = k * total + ((k & 1) ? (total - 1 - rank) : rank);
            if (it >= 256) continue;
            const int tokbase = b * SEQ, t0 = it * 32 + wid * 4, tq = t0 + fq;
            const int nch = ((it * 32 + 31) / 16 + 1 + 15) / 16;
#pragma unroll
            for (int i = 0; i < 16; ++i) myhist[lane + 64 * i] = 0u;
            if (lane < 16) myctl[lane] = 0u;
            h16x8 aq[2][2];
            { const h16* qrow = PROJ + O_QI + (size_t)(tokbase + t0 + (fr >> 2)) * 512 + (fr & 3) * 64 + 8 * fq;
#pragma unroll
              for (int hh = 0; hh < 2; ++hh)
#pragma unroll
                  for (int kk = 0; kk < 2; ++kk) aq[hh][kk] = *(const h16x8*)(qrow + hh * 256 + kk * 32); }
            float wv[8];
            { const h16x8 w8 = *(const h16x8*)(PROJ + O_WI + (size_t)(tokbase + tq) * 8);
#pragma unroll
              for (int h = 0; h < 8; ++h) wv[h] = (float)w8[h] * 0.04419417382415922f; }
            h16x2 wp[4];
#pragma unroll
            for (int h = 0; h < 4; ++h) { wp[h].x = (h16)wv[(h >> 1) * 4 + (h & 1) * 2]; wp[h].y = (h16)wv[(h >> 1) * 4 + (h & 1) * 2 + 1]; }
            __builtin_amdgcn_s_waitcnt(0);
            unsigned short* out = IDX + (size_t)(tokbase + tq) * 256;
            unsigned* blkflag = (unsigned*)(shm + 131072 + 1024);
            if (tid == 0) *blkflag = 0u;
            idx_sweep<1, true>(KIb, nch, stage, tid, tq, fr, fq, aq, wv, wp, myhist, 0u, myctl, mycand, out);
            {
                unsigned tot = 0u; const unsigned flo = myctl[fq * 4 + 1];
#pragma unroll
                for (int i = 0; i < 16; ++i) { const unsigned cb = myhist[fq * 256 + fr * 16 + i]; tot += ((unsigned)(fr * 16 + i) >= flo) ? cb : 0u; }
#pragma unroll
                for (int o = 1; o < 16; o <<= 1) tot += __shfl_xor(tot, o);
                const unsigned want0 = (unsigned)((tq + 1) < 256 ? (tq + 1) : 256);
                if (tot < want0) *blkflag = 1u;
                __syncthreads();
                if (*blkflag != 0u) {
#pragma unroll
                    for (int i = 0; i < 16; ++i) myhist[lane + 64 * i] = 0u;
                    asm volatile("s_waitcnt lgkmcnt(0)" ::: "memory");
                    idx_sweep<1, false>(KIb, nch, stage, tid, tq, fr, fq, aq, wv, wp, myhist, 0u, myctl, mycand, out);
                }
            }
            { const unsigned want = (unsigned)((tq + 1) < 256 ? (tq + 1) : 256);
              unsigned c[16]; unsigned lsum = 0u;
#pragma unroll
              for (int i = 0; i < 16; ++i) { c[i] = myhist[fq * 256 + fr * 16 + i]; lsum += c[i]; }
              unsigned incl = lsum;
#pragma unroll
              for (int o = 1; o < 16; o <<= 1) { const unsigned v = __shfl_down(incl, o); if (fr + o < 16) incl += v; }
              const unsigned above = incl - lsum;
              if (above < want && want <= incl) { unsigned cum = above; int bin = 0; bool found = false;
#pragma unroll
                  for (int i = 15; i >= 0; --i) { if (!found) { if (cum + c[i] >= want) { bin = i; found = true; } else cum += c[i]; } }
                  myctl[fq * 4] = (unsigned)(fr * 16 + bin); myctl[fq * 4 + 1] = want - cum; } }
            asm volatile("s_waitcnt lgkmcnt(0)" ::: "memory");
            const unsigned b0 = myctl[fq * 4];
            idx_sweep<2, false>(KIb, nch, stage, tid, tq, fr, fq, aq, wv, wp, myhist, b0, myctl, mycand, out);
            { const unsigned nc = myctl[fq * 4 + 3], need = myctl[fq * 4 + 1]; const int n = (int)(nc < 128u ? nc : 128u);
              for (int ci = fr; ci < n; ci += 16) { const unsigned ki = mycand[(fq * 128 + ci) * 2], ii = mycand[(fq * 128 + ci) * 2 + 1]; unsigned rk = 0u;
                  for (int jx = 0; jx < n; ++jx) { const unsigned kj = mycand[(fq * 128 + jx) * 2], ij = mycand[(fq * 128 + jx) * 2 + 1]; rk += (kj > ki || (kj == ki && ij < ii)) ? 1u : 0u; }
                  if (rk < need) { const unsigned pos = atomicAdd(&myctl[fq * 4 + 2], 1u); ((unsigned short*)myhist)[fq * 256 + (pos & 255u)] = (unsigned short)ii; } } }
            asm volatile("s_waitcnt lgkmcnt(0)" ::: "memory");
            { const uint4* sp = (const uint4*)((const unsigned short*)myhist + fq * 256 + fr * 16); uint4* dp = (uint4*)(out + fr * 16); dp[0] = sp[0]; dp[1] = sp[1]; }
            if (fr == 0) CNT[tokbase + tq] = (int)myctl[fq * 4 + 2];
            __syncthreads();
        }
    }
}

__device__ __forceinline__ void dsa_attend(const h16* PROJ, const unsigned short* IDX, const int* CNT, h16* MIXA, unsigned char* shm, unsigned* bar, unsigned xcc, unsigned xrank) {
    float* Pl = (float*)shm;
    unsigned short* selw = (unsigned short*)(shm + 32768);
    int tid_ = threadIdx.x; asm volatile("" : "+v"(tid_));
    const int tid = tid_, wid = tid >> 6, lane = tid & 63, fr = lane & 15, fq = lane >> 4;
    unsigned short* sel = selw + wid * 256;
    const int qq = 0;
    for (int u = 0; u < 2 * NBATCH; ++u) {
        int rank, total; if (!xcd_unit_rank(bar, xcc, xrank, 2 * NBATCH, u, rank, total)) continue;
        const int b = u >> 1, g = u & 1, tokbase = b * SEQ;
        for (int it = rank; it < 1024; it += total) {
            const int t = it * 8 + wid, tokq = tokbase + t; int nsel = __builtin_amdgcn_readfirstlane(CNT[tokq]); nsel = nsel < 1 ? 1 : (nsel > 256 ? 256 : nsel);
            *(unsigned long long*)(sel + 4 * lane) = *(const unsigned long long*)(IDX + (size_t)tokq * 256 + 4 * lane);
            asm volatile("s_waitcnt vmcnt(0) lgkmcnt(0)" ::: "memory");
            h16x8 qa[4];
#pragma unroll
            for (int kk = 0; kk < 4; ++kk) { h16x8 z;
#pragma unroll
                for (int e = 0; e < 8; ++e) z[e] = (h16)0.f;
                qa[kk] = z; }
            if (fr < 4) { const h16* qrow = PROJ + O_Q + (size_t)tokq * 1024 + (g * 4 + fr) * 128 + 16 * fq;
#pragma unroll
                for (int kk = 0; kk < 4; ++kk) qa[kk] = *(const h16x8*)(qrow + (kk & 1) * 8 + (kk >> 1) * 64); }
            long qa8[4];
#pragma unroll
            for (int kk = 0; kk < 4; ++kk) {
                int w0 = __builtin_amdgcn_cvt_pk_fp8_f32((float)qa[kk][0], (float)qa[kk][1], 0, false); w0 = __builtin_amdgcn_cvt_pk_fp8_f32((float)qa[kk][2], (float)qa[kk][3], w0, true);
                int w1 = __builtin_amdgcn_cvt_pk_fp8_f32((float)qa[kk][4], (float)qa[kk][5], 0, false); w1 = __builtin_amdgcn_cvt_pk_fp8_f32((float)qa[kk][6], (float)qa[kk][7], w1, true);
                qa8[kk] = (long)(((unsigned long long)(unsigned)w1 << 32) | (unsigned long long)(unsigned)w0); }
            f32x4 sacc[16];
            const unsigned char* kbase8 = (const unsigned char*)(PROJ + O_KG) + (size_t)(b * 2 + g) * SEQ * 128 + 16 * fq;
            {
                uint4 kf[16][2];
#pragma unroll
                for (int e = 0; e < 16; ++e) { const int slot = 16 * e + fr; const int idx = (int)sel[qq * 256 + (slot < nsel ? slot : nsel - 1)];
                    const unsigned char* krow = kbase8 + (size_t)idx * 128;
                    kf[e][0] = *(const uint4*)krow; kf[e][1] = *(const uint4*)(krow + 64); }
                __builtin_amdgcn_sched_barrier(0);
#pragma unroll
                for (int e = 0; e < 16; ++e) {
                    f32x4 a = (f32x4){0.f, 0.f, 0.f, 0.f};
#pragma unroll
                    for (int L = 0; L < 2; ++L) {
                        const long k0 = (long)(((unsigned long long)kf[e][L].y << 32) | (unsigned long long)kf[e][L].x), k1 = (long)(((unsigned long long)kf[e][L].w << 32) | (unsigned long long)kf[e][L].z);
                        a = __builtin_amdgcn_mfma_f32_16x16x32_fp8_fp8(qa8[2 * L], k0, a, 0, 0, 0); a = __builtin_amdgcn_mfma_f32_16x16x32_fp8_fp8(qa8[2 * L + 1], k1, a, 0, 0, 0); }
                    if (16 * e + fr >= nsel) a = (f32x4){-1e30f, -1e30f, -1e30f, -1e30f};
                    sacc[e] = a; }
                __builtin_amdgcn_sched_barrier(0);
            }
            f32x4 mx = sacc[0];
#pragma unroll
            for (int jt = 1; jt < 16; ++jt)
#pragma unroll
                for (int i = 0; i < 4; ++i) mx[i] = fmaxf(mx[i], sacc[jt][i]);
#pragma unroll
            for (int o = 1; o < 16; o <<= 1)
#pragma unroll
                for (int i = 0; i < 4; ++i) mx[i] = fmaxf(mx[i], __shfl_xor(mx[i], o));
            f32x4 sm = (f32x4){0.f, 0.f, 0.f, 0.f};
            const float sc = 0.08838834764831845f;
#pragma unroll
            for (int jt = 0; jt < 16; ++jt)
#pragma unroll
                for (int i = 0; i < 4; ++i) { const float e = __expf((sacc[jt][i] - mx[i]) * sc); sacc[jt][i] = e; sm[i] += e; }
#pragma unroll
            for (int o = 1; o < 16; o <<= 1)
#pragma unroll
                for (int i = 0; i < 4; ++i) sm[i] += __shfl_xor(sm[i], o);
            f32x4 inv;
#pragma unroll
            for (int i = 0; i < 4; ++i) inv[i] = 1.f / sm[i];
            if (fq == 0) {
#pragma unroll
                for (int jt = 0; jt < 16; ++jt) *(f32x4*)(Pl + ((size_t)wid * 256 + 16 * jt + fr) * 4) = sacc[jt] * inv;
            }
            asm volatile("s_waitcnt lgkmcnt(0)" ::: "memory");
            const int r8 = lane >> 3, c8 = lane & 7;
            const unsigned char* vbase8 = (const unsigned char*)(PROJ + O_VG) + (size_t)(b * 2 + g) * SEQ * 128 + 16 * c8;
            f32x2 oa2[4][8];
#pragma unroll
            for (int h = 0; h < 4; ++h)
#pragma unroll
                for (int d = 0; d < 8; ++d) oa2[h][d] = (f32x2){0.f, 0.f};
            for (int s0 = 0; s0 < nsel; s0 += 128) {
                uint4 vv[16];
#pragma unroll
                for (int e = 0; e < 16; ++e) { const int slot = s0 + 8 * e + r8; const int idx = (int)sel[qq * 256 + (slot < nsel ? slot : nsel - 1)];
                    vv[e] = *(const uint4*)(vbase8 + (size_t)idx * 128); }
                __builtin_amdgcn_sched_barrier(0);
#pragma unroll
                for (int e = 0; e < 16; ++e) { const int slot = s0 + 8 * e + r8;
                    if ((e & 3) == 0) __builtin_amdgcn_sched_barrier(0);
                    const f32x4 pp = *(const f32x4*)(Pl + ((size_t)wid * 256 + slot) * 4);
                    const f32x2 p0 = (f32x2){pp.x, pp.x}, p1 = (f32x2){pp.y, pp.y}, p2 = (f32x2){pp.z, pp.z}, p3 = (f32x2){pp.w, pp.w};
                    const unsigned wds[4] = {vv[e].x, vv[e].y, vv[e].z, vv[e].w};
#pragma unroll
                    for (int w = 0; w < 4; ++w) {
                        const f32x2 lo = __builtin_amdgcn_cvt_pk_f32_fp8((int)wds[w], false), hi = __builtin_amdgcn_cvt_pk_f32_fp8((int)wds[w], true);
                        oa2[0][2 * w] = __builtin_elementwise_fma(lo, p0, oa2[0][2 * w]); oa2[0][2 * w + 1] = __builtin_elementwise_fma(hi, p0, oa2[0][2 * w + 1]);
                        oa2[1][2 * w] = __builtin_elementwise_fma(lo, p1, oa2[1][2 * w]); oa2[1][2 * w + 1] = __builtin_elementwise_fma(hi, p1, oa2[1][2 * w + 1]);
                        oa2[2][2 * w] = __builtin_elementwise_fma(lo, p2, oa2[2][2 * w]); oa2[2][2 * w + 1] = __builtin_elementwise_fma(hi, p2, oa2[2][2 * w + 1]);
                        oa2[3][2 * w] = __builtin_elementwise_fma(lo, p3, oa2[3][2 * w]); oa2[3][2 * w + 1] = __builtin_elementwise_fma(hi, p3, oa2[3][2 * w + 1]); }
                }
            }
#pragma unroll
            for (int h = 0; h < 4; ++h)
#pragma unroll
                for (int d = 0; d < 8; ++d) { f32x2 v = oa2[h][d];
                    v.x += __shfl_xor(v.x, 8); v.y += __shfl_xor(v.y, 8); v.x += __shfl_xor(v.x, 16); v.y += __shfl_xor(v.y, 16); v.x += __shfl_xor(v.x, 32); v.y += __shfl_xor(v.y, 32); oa2[h][d] = v; }
            if (r8 == 0) {
                h16* orow = MIXA + (size_t)tokq * DM + (g * 4) * 128 + 16 * c8;
#pragma unroll
                for (int h = 0; h < 4; ++h) { h16x8 w0, w1;
#pragma unroll
                    for (int d = 0; d < 4; ++d) { w0[2 * d] = (h16)oa2[h][d].x; w0[2 * d + 1] = (h16)oa2[h][d].y; w1[2 * d] = (h16)oa2[h][4 + d].x; w1[2 * d + 1] = (h16)oa2[h][4 + d].y; }
                    *(h16x8*)(orow + h * 128) = w0; *(h16x8*)(orow + h * 128 + 8) = w1; }
            }
            asm volatile("s_waitcnt lgkmcnt(0)" ::: "memory");
        }
    }
}

__device__ __forceinline__ Gemm mk_gemm(const h16* A, int lda, const h16* Bt, int ldb, int M, int N, int K, int nB = 1, size_t sA = 0, size_t sB = 0) {
    Gemm g; g.A = A; g.Bt = Bt; g.lda = lda; g.ldb = ldb; g.nM = M / 256; g.nN = N / 256; g.nB = nB; g.K = K; g.strideA = sA; g.strideB = sB; return g;
}

__device__ __forceinline__ int opaque(int v) { asm volatile("" : "+v"(v)); return v; }
enum { K_FUP0 = 0, K_FDN0, K_LN0, K_MIE, K_S5A, K_CARRY, K_S5B, K_GLU, K_MO, K_LN1, K_FUP1, K_FDN1, K_LN2, K_PLE, K_MIO, K_DSA };
constexpr unsigned long long tbl_even() { const int k[13] = {K_FUP0, K_FDN0, K_LN0, K_MIE, K_S5A, K_S5B, K_GLU, K_MO, K_LN1, K_FUP1, K_FDN1, K_LN2, K_PLE}; unsigned long long r = 0; for (int i = 0; i < 13; ++i) r |= (unsigned long long)k[i] << (4 * i); return r; }
constexpr unsigned long long tbl_odd() { const int k[12] = {K_FUP0, K_FDN0, K_LN0, K_MIO, K_DSA, K_CARRY  , K_MO, K_LN1, K_FUP1, K_FDN1, K_LN2, K_PLE}; unsigned long long r = 0; for (int i = 0; i < 12; ++i) r |= (unsigned long long)k[i] << (4 * i); return r; }

__global__ void __launch_bounds__(512, 2) fwd_megakernel(Params P) {
    extern __shared__ __attribute__((aligned(16))) unsigned char shm[];
    cg::grid_group grid = cg::this_grid();
    LAS unsigned char* lds = (LAS unsigned char*)shm;
    volatile LAS unsigned* xbst = (volatile LAS unsigned*)(lds + LDS_BYTES - 16);
    if (threadIdx.x == 0) { const unsigned x_ = xb_xcc_id(); xbst[0] = 0u; xbst[1] = 0u; xbst[2] = xb_add(&((unsigned*)(P.ws + OFF_BAR))[XB_XCNT(x_)], 1u); xbst[3] = x_; }
    __syncthreads();

    if (blockIdx.x < 64) s5_build(P, blockIdx.x >> 5, blockIdx.x & 31, (float*)shm);
    prep_transposes(P, (float*)shm);
    cvt_pass(P.x, (h16*)(P.ws + OFF_MIXA), (size_t)NTOK * DM, nullptr);
    grid.sync();

    for (int i = 0; i < DEPTH; ++i) {
        const bool even = (i & 1) == 0; const int nst = even ? 13 : 12; const unsigned long long tbl = even ? tbl_even() : tbl_odd();
        for (int st = 0; st < nst; ++st) {
            const int kind = (int)((tbl >> (4 * st)) & 15ull), j = i >> 1;
            unsigned long long ka_ = (unsigned long long)__builtin_amdgcn_kernarg_segment_ptr(); asm volatile("" : "+s"(ka_));
            const __attribute__((address_space(4))) Params* PK = (const __attribute__((address_space(4))) Params*)ka_;
            unsigned char* ws = PK->ws;
            float* H = PK->out;
            h16* H16 = (h16*)(ws + OFF_H16);
            h16* MIXA = (h16*)(ws + OFF_MIXA);
            h16* R1 = (h16*)(ws + OFF_R1);
            h16* UG = (h16*)(ws + OFF_R1 + R1_UG);
            float* SLOC = (float*)(ws + OFF_R1 + R1_SLOC);
            h16* Z = (h16*)(ws + OFF_R1 + R1_Z);
            h16* P16 = (h16*)(ws + OFF_P16);
            EpiArgs E{};
            switch (kind) {
            case K_FUP0: case K_FUP1: {
                const int li = i * 2 + (kind == K_FUP1 ? 1 : 0);
                E.h0 = R1;
                gemm_phase<E_SWIGLU>(lds, mk_gemm(kind == K_FUP0 ? MIXA : H16, DM, (const h16*)(ws + OFF_W13 + li * SZ_W13), DM, NTOK, 5632, DM), E);
            } break;
            case K_FDN0: case K_FDN1: case K_MO: {
                E.ch0 = (kind == K_FDN0) ? MIXA : H16; E.h0 = H16;
                if (kind == K_MO) { E.s0 = 1.f;
                    gemm_phase<E_RES>(lds, mk_gemm(MIXA, DM, (const h16*)(ws + (even ? OFF_ABOUT : OFF_COUT) + j * SZ_SQ), DM, NTOK, DM, DM), E);
                } else { const int li = i * 2 + (kind == K_FDN1 ? 1 : 0); E.s0 = 0.5f;
                    gemm_phase<E_RES>(lds, mk_gemm(R1, DFF, (const h16*)(ws + OFF_W2T + li * SZ_W2T), DFF, NTOK, DM, DFF), E); }
            } break;
            case K_LN0: case K_LN1: case K_LN2: {
                const int idx = i * 3 + (kind == K_LN0 ? 0 : (kind == K_LN1 ? 1 : 2));
                ln_pass(H16, PK->ln_g + (size_t)idx * DM, PK->ln_b + (size_t)idx * DM);
                if (kind == K_LN1) cvt_pass(PK->p + (size_t)i * NTOK * 256, P16, (size_t)NTOK * 256, nullptr);
                if (kind == K_LN2) { E.h0 = R1;
                    gemm_phase<E_PP>(lds, mk_gemm(P16, 256, (const h16*)(ws + OFF_WPT + i * SZ_WPT), 256, NTOK, DM, 256), E); }
            } break;
            case K_MIE: {
                E.h0 = R1; E.h1 = UG;
                gemm_phase<E_PROJ_EVEN>(lds, mk_gemm(H16, DM, (const h16*)(ws + OFF_ABIN + j * SZ_ABIN), DM, NTOK, 2048, DM), E);
            } break;
            case K_S5A: {
                E.f0 = SLOC;
                gemm_phase<E_S5A>(lds, mk_gemm(UG, 640, (const h16*)(ws + OFF_W1M + j * SZ_W1M), 512, 1024, 256, 512, 32, (size_t)1024 * 640, (size_t)256 * 512), E);
                for (int L = blockIdx.x; L < NBATCH * 32; L += gridDim.x) { __syncthreads(); carry_unit(SLOC, UG, (const float*)(ws + OFF_A32) + (size_t)j * 32 * 64 * 2, shm, L & 3, L >> 2); }
                conv_pass(R1, PK->convw + (size_t)j * 1536, MIXA);
            } break;
            case K_CARRY:
                dsa_attend(R1, (const unsigned short*)(ws + OFF_R1 + R1_IDX), (const int*)(ws + OFF_R1 + R1_CNT), MIXA, shm, (unsigned*)(ws + OFF_BAR), xbst[3], xbst[2]);
                break;
            case K_S5B: {
                E.ch0 = UG; E.cf0 = PK->s5d + (size_t)j * 512; E.h0 = Z;
                gemm_phase<E_S5B>(lds, mk_gemm(UG, 640, (const h16*)(ws + OFF_M2 + j * SZ_M2), 640, 1024, 512, 640, 32, (size_t)1024 * 640, (size_t)512 * 640), E);
            } break;
            case K_GLU: {
                E.ch0 = Z; E.cf0 = PK->bglu + (size_t)j * 512; E.h0 = MIXA;
                gemm_phase<E_GLU>(lds, mk_gemm(Z, 512, (const h16*)(ws + OFF_WGLU + j * SZ_WGLU), 512, NTOK, 512, 512), E);
            } break;
            case K_MIO: {
                E.h0 = R1; E.pos = PK->pos;
                gemm_phase<E_PROJ_ODD>(lds, mk_gemm(H16, DM, (const h16*)(ws + OFF_CIN + j * SZ_CIN), DM, NTOK, 2304, DM), E);
            } break;
            case K_DSA: dsa_select(R1, (unsigned short*)(ws + OFF_R1 + R1_IDX), (int*)(ws + OFF_R1 + R1_CNT), shm, (unsigned*)(ws + OFF_BAR), xbst[3], xbst[2]); break;
            case K_PLE: {
                E.f0 = (i == DEPTH - 1) ? H : nullptr; E.ch0 = R1; E.ch1 = H16; E.h0 = MIXA;
                gemm_phase<E_PLE>(lds, mk_gemm(H16, DM, (const h16*)(ws + OFF_WGT + i * SZ_SQ), DM, NTOK, DM, DM), E);
            } break;
            }
            xcd_barrier((unsigned*)(ws + OFF_BAR), xbst);
        }
    }
}

extern "C" void kernel_launch(void* const* d_in, const int* in_sizes, int n_in, void* d_out, int out_size, void* d_ws, size_t ws_size, hipStream_t stream) {
    static int grid_blocks = 0;
    if (grid_blocks == 0) {
        if (n_in != 25 || out_size != NTOK * DM || ws_size < WS_END) { fprintf(stderr, "kernel_launch: unexpected shapes (n_in %d, out %d, ws %zu, need %zu)\n", n_in, out_size, ws_size, (size_t)WS_END); grid_blocks = -1; return; }
        int dev = 0, cus = 0, per_cu = 0;
        hipGetDevice(&dev);
        hipDeviceGetAttribute(&cus, hipDeviceAttributeMultiprocessorCount, dev);
        if (hipFuncSetAttribute((const void*)fwd_megakernel, hipFuncAttributeMaxDynamicSharedMemorySize, LDS_BYTES) != hipSuccess) { fprintf(stderr, "kernel_launch: hipFuncSetAttribute failed\n"); grid_blocks = -1; return; }
        if (hipOccupancyMaxActiveBlocksPerMultiprocessor(&per_cu, (const void*)fwd_megakernel, 512, LDS_BYTES) != hipSuccess || per_cu < 1) { fprintf(stderr, "kernel_launch: occupancy query says %d\n", per_cu); per_cu = 1; }
        (void)hipGetLastError();
        grid_blocks = cus * per_cu;
    }
    if (grid_blocks < 0) return;
    Params p{};
    p.x = (const float*)d_in[0]; p.p = (const float*)d_in[1]; p.pos = (const int*)d_in[2];
    p.ln_g = (const float*)d_in[3]; p.ln_b = (const float*)d_in[4]; p.w1 = (const float*)d_in[5]; p.w3 = (const float*)d_in[6]; p.w2 = (const float*)d_in[7];
    p.plep = (const float*)d_in[8]; p.pleg = (const float*)d_in[9]; p.abin = (const float*)d_in[10]; p.about = (const float*)d_in[11]; p.convw = (const float*)d_in[12];
    p.lamre = (const float*)d_in[13]; p.lamim = (const float*)d_in[14]; p.logdt = (const float*)d_in[15]; p.bre = (const float*)d_in[16]; p.bim = (const float*)d_in[17];
    p.cre = (const float*)d_in[18]; p.cim = (const float*)d_in[19]; p.s5d = (const float*)d_in[20]; p.wglu = (const float*)d_in[21]; p.bglu = (const float*)d_in[22];
    p.cin = (const float*)d_in[23]; p.cout = (const float*)d_in[24];
    p.out = (float*)d_out; p.ws = (unsigned char*)d_ws;
    if (hipMemsetAsync((char*)d_ws + OFF_BAR, 0, 16384, stream) != hipSuccess) { fprintf(stderr, "kernel_launch: memset of barrier words failed\n"); return; }
    void* args[] = {&p};
    hipError_t e = hipLaunchCooperativeKernel((const void*)fwd_megakernel, dim3(grid_blocks), dim3(512), args, LDS_BYTES, stream);
    if (e != hipSuccess) fprintf(stderr, "cooperative launch failed: %s (grid %d)\n", hipGetErrorString(e), grid_blocks);
}
```

```cpp
#include <hip/hip_runtime.h>
#include <hip/hip_cooperative_groups.h>
#include <cstdio>
namespace cg = cooperative_groups;

#define LAS __attribute__((address_space(3)))
typedef _Float16 h16;
typedef _Float16 h16x8 __attribute__((ext_vector_type(8)));
typedef _Float16 h16x4 __attribute__((ext_vector_type(4)));
typedef _Float16 h16x2 __attribute__((ext_vector_type(2)));
typedef float f32x4 __attribute__((ext_vector_type(4)));
typedef float f32x2 __attribute__((ext_vector_type(2)));

constexpr int NTOK = 32768, DM = 1024, DFF = 2816, SEQ = 8192, NBATCH = 4, DEPTH = 4;
constexpr float DN_ALPHA = 1.6817928305074292f;
constexpr float LN_EPS = 1e-5f;
constexpr int LDS_BYTES = 147456;

constexpr size_t SZ_W13 = (size_t)5632 * 1024 * 2, SZ_W2T = (size_t)1024 * 2816 * 2, SZ_WPT = (size_t)1024 * 256 * 2, SZ_SQ = (size_t)1024 * 1024 * 2;
constexpr size_t SZ_ABIN = (size_t)2048 * 1024 * 2, SZ_WGLU = (size_t)512 * 512 * 2, SZ_CIN = (size_t)2304 * 1024 * 2;
constexpr size_t SZ_W1M = (size_t)32 * 256 * 512 * 2, SZ_M2 = (size_t)32 * 512 * 640 * 2;
constexpr size_t OFF_W13 = 0;
constexpr size_t OFF_W2T = OFF_W13 + 8 * SZ_W13;
constexpr size_t OFF_WPT = OFF_W2T + 8 * SZ_W2T;
constexpr size_t OFF_WGT = OFF_WPT + 4 * SZ_WPT;
constexpr size_t OFF_ABIN = OFF_WGT + 4 * SZ_SQ;
constexpr size_t OFF_ABOUT = OFF_ABIN + 2 * SZ_ABIN;
constexpr size_t OFF_WGLU = OFF_ABOUT + 2 * SZ_SQ;
constexpr size_t OFF_CIN = OFF_WGLU + 2 * SZ_WGLU;
constexpr size_t OFF_COUT = OFF_CIN + 2 * SZ_CIN;
constexpr size_t OFF_W1M = OFF_COUT + 2 * SZ_SQ;
constexpr size_t OFF_M2 = OFF_W1M + 2 * SZ_W1M;
constexpr size_t OFF_A32 = OFF_M2 + 2 * SZ_M2;
constexpr size_t OFF_H16 = OFF_A32 + 65536;
constexpr size_t OFF_R1 = OFF_H16 + (size_t)NTOK * DM * 2;
constexpr size_t SZ_R1 = (size_t)201326592;
constexpr size_t OFF_MIXA = OFF_R1 + SZ_R1;
constexpr size_t OFF_P16 = OFF_MIXA + (size_t)NTOK * DM * 2;
constexpr size_t OFF_BAR = OFF_P16 + (size_t)NTOK * 256 * 2;
constexpr size_t WS_END = OFF_BAR + 16384;
constexpr size_t R1_UG = (size_t)NTOK * 1536 * 2;
constexpr size_t R1_SLOC = R1_UG + (size_t)32 * 1024 * 640 * 2;
constexpr size_t R1_Z = R1_SLOC + (size_t)32 * 1024 * 128 * 4;
static_assert(R1_Z + (size_t)NTOK * 512 * 2 <= SZ_R1, "R1 layout");
constexpr size_t O_Q = 0, O_KG = (size_t)NTOK * 1024, O_VG = O_KG + (size_t)NTOK * 256, O_QI = O_VG + (size_t)NTOK * 256, O_KI = O_QI + (size_t)NTOK * 512, O_WI = O_KI + (size_t)NTOK * 64;
constexpr size_t R1_IDX = (O_WI + (size_t)NTOK * 8) * 2;
constexpr size_t R1_CNT = R1_IDX + (size_t)NTOK * 256 * 2;
static_assert(R1_CNT + (size_t)NTOK * 4 <= SZ_R1, "R1 layout (odd)");

struct Params {
    const float* x; const float* p; const int* pos;
    const float *ln_g, *ln_b, *w1, *w3, *w2, *plep, *pleg, *abin, *about, *convw, *lamre, *lamim, *logdt, *bre, *bim, *cre, *cim, *s5d, *wglu, *bglu, *cin, *cout;
    float* out; unsigned char* ws;
};

__device__ __forceinline__ float sigmoidf_(float x) { return __builtin_amdgcn_rcpf(1.f + __expf(-x)); }
__device__ __forceinline__ float gelu_tanh(float x) { const float u = 0.7978845608028654f * (x + 0.044715f * x * x * x); return 0.5f * x * (2.f - 2.f * __builtin_amdgcn_rcpf(1.f + __expf(2.f * u))); }
__device__ __forceinline__ h16x4 cvt4(f32x4 v) { h16x4 r; r.x = (h16)v.x; r.y = (h16)v.y; r.z = (h16)v.z; r.w = (h16)v.w; return r; }
__device__ __forceinline__ float wave_sum(float v) {
#pragma unroll
    for (int o = 1; o < 64; o <<= 1) v += __shfl_xor(v, o);
    return v;
}
__device__ __forceinline__ void rope_sc(float pos, float inv, float& c, float& s) {
    const float ang = pos * inv;
    const double a = (double)ang;
    const double n = __builtin_rint(a * 0.15915494309189535);
    const float r = (float)(a - n * 6.283185307179586);
    s = __sinf(r); c = __cosf(r);
}

constexpr int BM = 256, BK = 64, HALF = 128, HTB = HALF * BK * 2, NXCD = 8, WGM = 8;
__device__ __forceinline__ int lds_byte(int r, int c) { const int st = (r >> 4) * 2 + (c >> 5), rr = r & 15, cc = c & 31, ob = rr * 64 + cc * 2; return st * 1024 + (ob ^ (((ob >> 9) & 1) << 5)); }
__device__ __forceinline__ void stage_rc(int b, int& R, int& C) { const int st = b / 1024, sb = b % 1024, swz = sb ^ (((sb >> 9) & 1) << 5); R = (st >> 1) * 16 + swz / 64; C = (st & 1) * 32 + (swz % 64) / 2; }

struct Unit { int pb, pm, pn; };
struct Gemm { const h16* A; const h16* Bt; int lda, ldb, nM, nN, nB, K; size_t strideA, strideB; };
struct EpiArgs { float* f0; const float* cf0; h16* h0; h16* h1; const h16* ch0; const h16* ch1; const int* pos; float s0; };

__device__ __forceinline__ bool unit_next(const Gemm& g, int i, Unit& u) {
    const int nwg = g.nM * g.nN; const long L = (long)i * gridDim.x + blockIdx.x; if (L >= (long)nwg * g.nB) return false;
    u.pb = (int)(L / nwg); int wgid = (int)(L % nwg);
    { const int q = nwg / NXCD, r = nwg % NXCD, xcd = wgid % NXCD, off = wgid / NXCD; wgid = (xcd < r ? xcd * (q + 1) : r * (q + 1) + (xcd - r) * q) + off; }
    const int nig = WGM * g.nN, gid = wgid / nig, fm = gid * WGM, gsz = (g.nM - fm) < WGM ? (g.nM - fm) : WGM;
    u.pm = fm + ((wgid % nig) % gsz); u.pn = (wgid % nig) / gsz; return true;
}

enum { E_SWIGLU = 0, E_RES = 1, E_PROJ_EVEN = 2, E_S5A = 3, E_S5B = 4, E_GLU = 5, E_PROJ_ODD = 6, E_PP = 7, E_PLE = 8 };

template <int MODE>
__device__ __forceinline__ void epilogue(const f32x4 (&acc)[2][2][4][2], const Unit& u, const EpiArgs& E, int wr, int wc, int fr, int fq) {
    const int row0 = u.pm * BM + wr * 64 + fr, tc0 = wc * 32 + 4 * fq;
    h16* obase = nullptr; int orstride = 0, obstride = 0;
    if constexpr (MODE == E_PROJ_ODD) {
        if (u.pn < 4) { obase = E.h0 + O_Q + u.pn * 256; orstride = 1024; obstride = 128; }
        else if (u.pn < 6) { obase = E.h0 + (u.pn == 4 ? O_KG : O_VG) + (size_t)((u.pm * BM) >> 13) * SEQ * 128; orstride = 128; obstride = SEQ * 128; }
        else if (u.pn < 8) { obase = E.h0 + O_QI + (u.pn - 6) * 256; orstride = 512; obstride = 128; }
        else { obase = E.h0 + O_KI; orstride = 64; obstride = 0; }
    }
#pragma unroll
    for (int ai = 0; ai < 2; ++ai) {
    h16x8 pre[4][2];
    if constexpr (MODE == E_RES || MODE == E_PLE || MODE == E_GLU) {
        const h16* pb = (MODE == E_PLE) ? E.ch1 : E.ch0; const int pld = (MODE == E_GLU) ? 512 : DM;
#pragma unroll
        for (int m = 0; m < 4; ++m)
#pragma unroll
            for (int bj = 0; bj < 2; ++bj) pre[m][bj] = *(const h16x8*)(pb + (size_t)(row0 + ai * HALF + m * 16) * pld + u.pn * 256 + bj * 128 + wc * 32 + 8 * fq);
    }
#pragma unroll
        for (int m = 0; m < 4; ++m) {
            int row = row0 + ai * HALF + m * 16; asm volatile("" : "+v"(row));
            if constexpr (MODE == E_SWIGLU) {
#pragma unroll
                for (int bj = 0; bj < 2; ++bj) {
                    const f32x4 a = acc[ai][bj][m][0], b = acc[ai][bj][m][1]; f32x4 o;
#pragma unroll
                    for (int j = 0; j < 4; ++j) o[j] = a[j] * sigmoidf_(a[j]) * b[j];
                    const int hc = u.pn * 128 + bj * 64 + wc * 16 + 4 * fq;
                    *(h16x4*)(E.h0 + (size_t)row * DFF + hc) = cvt4(o);
                }
            } else if constexpr (MODE == E_PROJ_ODD) {
                const float pos = (float)E.pos[row];
                float cs[4], sn[4];
                const bool rot_a = (u.pn <= 4) && (wc == 0);
                const bool rot_i = (u.pn >= 6) && ((u.pn < 8) ? ((wc & 1) == 0) : (wc == 0));
                if (rot_a) {
#pragma unroll
                    for (int j = 0; j < 4; ++j) rope_sc(pos, exp2f(-(float)(4 * fq + j) * (18.931568569324174f / 16.f)), cs[j], sn[j]);
                } else if (rot_i) {
#pragma unroll
                    for (int j = 0; j < 4; ++j) rope_sc(pos, exp2f(-(float)((4 * fq + j) & 7) * (18.931568569324174f / 8.f)), cs[j], sn[j]);
                }
#pragma unroll
                for (int bj = 0; bj < 2; ++bj) {
                    f32x4 v0 = acc[ai][bj][m][0], v1 = acc[ai][bj][m][1];
                    if (rot_a) {
                        f32x4 t0, t1;
#pragma unroll
                        for (int j = 0; j < 4; ++j) { t0[j] = v0[j] * cs[j] - v1[j] * sn[j]; t1[j] = v1[j] * cs[j] + v0[j] * sn[j]; }
                        v0 = t0; v1 = t1;
                    }
                    if (u.pn >= 6) {
                        f32x4 y;
#pragma unroll
                        for (int j = 0; j < 4; ++j) y[j] = __shfl_xor(v0[j], 32);
                        if (rot_i && (u.pn < 8 || bj == 0)) {
#pragma unroll
                            for (int j = 0; j < 4; ++j) v0[j] = (fq < 2) ? (v0[j] * cs[j] - y[j] * sn[j]) : (v0[j] * cs[j] + y[j] * sn[j]);
                        }
                    }
                    if (u.pn == 4 || u.pn == 5) {
                        unsigned char* o8 = (unsigned char*)(E.h0 + (u.pn == 4 ? O_KG : O_VG)) + ((size_t)((row >> 13) * 2 + bj) * SEQ + (row & (SEQ - 1))) * 128 + tc0;
                        int w0 = __builtin_amdgcn_cvt_pk_fp8_f32(v0[0], v0[1], 0, false); w0 = __builtin_amdgcn_cvt_pk_fp8_f32(v0[2], v0[3], w0, true);
                        int w1 = __builtin_amdgcn_cvt_pk_fp8_f32(v1[0], v1[1], 0, false); w1 = __builtin_amdgcn_cvt_pk_fp8_f32(v1[2], v1[3], w1, true);
                        *(int*)o8 = w0; *(int*)(o8 + 16) = w1;
                    } else if (u.pn < 8 || (bj == 0 && wc < 2)) { h16* o = obase + (size_t)row * orstride + bj * obstride + tc0; *(h16x4*)o = cvt4(v0); *(h16x4*)(o + 16) = cvt4(v1); }
                    else if (bj == 0 && wc == 2 && fq < 2) *(h16x4*)(E.h0 + O_WI + (size_t)row * 8 + 4 * fq) = cvt4(v0);
                }
            } else if constexpr (MODE == E_RES || MODE == E_PLE || MODE == E_PP || MODE == E_GLU) {
#pragma unroll
                for (int bj = 0; bj < 2; ++bj) {
                    const int col = u.pn * 256 + bj * 128 + wc * 32 + 8 * fq;
                    const f32x4 v0 = acc[ai][bj][m][0], v1 = acc[ai][bj][m][1];
                    float vv[8] = {v0[0], v0[1], v0[2], v0[3], v1[0], v1[1], v1[2], v1[3]};
                    h16x8 o;
                    if constexpr (MODE == E_RES) {
                        const h16x8 hh = pre[m][bj];
#pragma unroll
                        for (int j = 0; j < 8; ++j) o[j] = (h16)((float)hh[j] * DN_ALPHA + vv[j] * E.s0);
                        *(h16x8*)(E.h0 + (size_t)row * DM + col) = o;
                    } else if constexpr (MODE == E_GLU) {
                        const h16x8 zz = pre[m][bj]; const f32x4 b0 = *(const f32x4*)(E.cf0 + col), b1 = *(const f32x4*)(E.cf0 + col + 4);
                        const float bb[8] = {b0[0], b0[1], b0[2], b0[3], b1[0], b1[1], b1[2], b1[3]};
#pragma unroll
                        for (int j = 0; j < 8; ++j) o[j] = (h16)((float)zz[j] * sigmoidf_(vv[j] + bb[j]));
                        *(h16x8*)(E.h0 + (size_t)row * DM + 512 + col) = o;
                    } else if constexpr (MODE == E_PP) {
#pragma unroll
                        for (int j = 0; j < 8; ++j) o[j] = (h16)vv[j];
                        *(h16x8*)(E.h0 + (size_t)row * DM + col) = o;
                    } else {
                        const h16x8 hh = pre[m][bj]; const h16x8 pp = *(const h16x8*)(E.ch0 + (size_t)row * DM + col); float of[8];
#pragma unroll
                        for (int j = 0; j < 8; ++j) { of[j] = (float)hh[j] + (float)pp[j] * sigmoidf_(vv[j]); o[j] = (h16)of[j]; }
                        if (E.f0) { *(f32x4*)(E.f0 + (size_t)row * DM + col) = (f32x4){of[0], of[1], of[2], of[3]}; *(f32x4*)(E.f0 + (size_t)row * DM + col + 4) = (f32x4){of[4], of[5], of[6], of[7]}; }
                        *(h16x8*)(E.h0 + (size_t)row * DM + col) = o;
                    }
                }
            } else {
#pragma unroll
                for (int bj = 0; bj < 2; ++bj)
#pragma unroll
                    for (int n = 0; n < 2; ++n) {
                        const int tc = bj * 128 + tc0 + n * 16, col = u.pn * 256 + tc;
                        const f32x4 v = acc[ai][bj][m][n];
                        if constexpr (MODE == E_RES) {
                            const h16x4 hh = *(const h16x4*)(E.ch0 + (size_t)row * DM + col); f32x4 y;
#pragma unroll
                            for (int j = 0; j < 4; ++j) y[j] = (float)hh[j] * DN_ALPHA + v[j] * E.s0;
                            *(h16x4*)(E.h0 + (size_t)row * DM + col) = cvt4(y);
                        } else if constexpr (MODE == E_PROJ_EVEN) {
                            if (u.pn < 6) *(h16x4*)(E.h0 + (size_t)row * 1536 + col) = cvt4(v);
                            else { const int ch = col - 1536, g = ch >> 4, ci = ch & 15;
                                *(h16x4*)(E.h1 + ((size_t)g * 1024 + (row >> 5)) * 640 + (row & 31) * 16 + ci) = cvt4(v); }
                        } else if constexpr (MODE == E_S5A) {
                            if (bj == 0) *(f32x4*)(E.f0 + ((size_t)u.pb * 1024 + row) * 128 + tc) = v * (1.f / 1024.f);
                        } else if constexpr (MODE == E_S5B) {
                            const int t = col >> 4, co = col & 15, ch = u.pb * 16 + co;
                            const h16x4 uu = *(const h16x4*)(E.ch0 + ((size_t)u.pb * 1024 + row) * 640 + col);
                            const f32x4 d = *(const f32x4*)(E.cf0 + ch); f32x4 z;
#pragma unroll
                            for (int j = 0; j < 4; ++j) z[j] = gelu_tanh(v[j] * (1.f / 1024.f) + d[j] * (float)uu[j]);
                            *(h16x4*)(E.h0 + ((size_t)row * 32 + t) * 512 + ch) = cvt4(z);
                        } else if constexpr (MODE == E_GLU) {
                            const h16x4 zz = *(const h16x4*)(E.ch0 + (size_t)row * 512 + col); const f32x4 bb = *(const f32x4*)(E.cf0 + col); f32x4 o;
#pragma unroll
                            for (int j = 0; j < 4; ++j) o[j] = (float)zz[j] * sigmoidf_(v[j] + bb[j]);
                            *(h16x4*)(E.h0 + (size_t)row * DM + 512 + col) = cvt4(o);
                        } else if constexpr (MODE == E_PP) {
                            *(h16x4*)(E.h0 + (size_t)row * DM + col) = cvt4(v);
                        } else if constexpr (MODE == E_PLE) {
                            const h16x4 hh = *(const h16x4*)(E.ch1 + (size_t)row * DM + col); const h16x4 pp = *(const h16x4*)(E.ch0 + (size_t)row * DM + col); f32x4 o;
#pragma unroll
                            for (int j = 0; j < 4; ++j) o[j] = (float)hh[j] + (float)pp[j] * sigmoidf_(v[j]);
                            if (E.f0) *(f32x4*)(E.f0 + (size_t)row * DM + col) = o;
                            *(h16x4*)(E.h0 + (size_t)row * DM + col) = cvt4(o);
                        }
                    }
            }
            __builtin_amdgcn_sched_barrier(0);
        }
    }
}

template <int MODE>
__device__ __forceinline__ void gemm_phase(LAS unsigned char* lds, const Gemm g, const EpiArgs E) {
    int tid_ = threadIdx.x; asm volatile("" : "+v"(tid_));
    const int tid = tid_, wid = __builtin_amdgcn_readfirstlane(tid >> 6), lane = tid & 63, wr = wid >> 2, wc = wid & 3, fr = lane & 15, fq = lane >> 4;
    const int K = g.K, nt = K / BK;
    unsigned voffA[2], voffB[2];
    constexpr bool PERM = (MODE == E_RES || MODE == E_PLE || MODE == E_PP || MODE == E_GLU);
#pragma unroll
    for (int i = 0; i < 2; ++i) { int R, C; stage_rc(tid * 16 + i * 8192, R, C);
        int Rb = R; if (PERM) { const int rho = R & 31, nn = rho >> 4, ii = rho & 15; Rb = (R & ~31) + 8 * (ii >> 2) + 4 * nn + (ii & 3); }
        voffA[i] = (unsigned)(R * g.lda + C) * 2u; voffB[i] = (unsigned)(Rb * g.ldb + C) * 2u; }
    const size_t kstep = (size_t)(BK * 2);
    const size_t hstepA = (size_t)HALF * g.lda * 2, hstepB = (size_t)HALF * g.ldb * 2;
    const unsigned ldsw = (unsigned)wid * 1024u;
    const int aoff = lds_byte(wr * 64 + fr, fq * 8), boff = lds_byte(wc * 32 + fr, fq * 8);
#define G_SA(b, h) (((b) * 2 + (h)) * HTB)
#define G_SB(b, h) ((4 + (b) * 2 + (h)) * HTB)
#define G_STAGE(bufoff, gbase, voff) do { _Pragma("unroll") for (int _i = 0; _i < 2; ++_i) \
        __builtin_amdgcn_global_load_lds((const unsigned*)((const char*)(gbase) + (voff)[_i]), (LAS unsigned*)(lds + (bufoff) + ldsw + _i * 8192), 16, 0, 0); } while (0)
#define G_LDA(dst, b, h) do { _Pragma("unroll") for (int m = 0; m < 4; ++m) _Pragma("unroll") for (int k = 0; k < 2; ++k) dst[m][k] = *(const LAS h16x8*)(lds + G_SA(b, h) + aoff + m * 2048 + k * 1024); } while (0)
#define G_LDB(dst, b, h) do { _Pragma("unroll") for (int n = 0; n < 2; ++n) _Pragma("unroll") for (int k = 0; k < 2; ++k) dst[n][k] = *(const LAS h16x8*)(lds + G_SB(b, h) + boff + n * 2048 + k * 1024); } while (0)
#define G_MMA(ai, bj, At, Bt) do { __builtin_amdgcn_s_setprio(1); _Pragma("unroll") for (int m = 0; m < 4; ++m) _Pragma("unroll") for (int n = 0; n < 2; ++n) _Pragma("unroll") for (int k = 0; k < 2; ++k) \
        acc[ai][bj][m][n] = __builtin_amdgcn_mfma_f32_16x16x32_f16(Bt[n][k], At[m][k], acc[ai][bj][m][n], 0, 0, 0); __builtin_amdgcn_s_setprio(0); } while (0)
#define G_WAIT_V(n) asm volatile("s_waitcnt vmcnt(" #n ")" ::: "memory")
#define G_WAIT_L(n) asm volatile("s_waitcnt lgkmcnt(" #n ")" ::: "memory")
#define G_BAR __builtin_amdgcn_s_barrier()
#define G_SCHED __builtin_amdgcn_sched_barrier(0)
    Unit cur, nxt; int ui = 0;
    if (!unit_next(g, 0, cur)) return;
    f32x4 acc[2][2][4][2];
#pragma unroll
    for (int a = 0; a < 2; ++a)
#pragma unroll
        for (int b = 0; b < 2; ++b)
#pragma unroll
            for (int m = 0; m < 4; ++m)
#pragma unroll
                for (int n = 0; n < 2; ++n) acc[a][b][m][n] = (f32x4){0.f, 0.f, 0.f, 0.f};
    h16x8 At[4][2], B0[2][2], B1[2][2];
    const char* cA = (const char*)(g.A + (size_t)cur.pb * g.strideA) + (size_t)cur.pm * 2 * hstepA;
    const char* cB = (const char*)(g.Bt + (size_t)cur.pb * g.strideB) + (size_t)cur.pn * 2 * hstepB;
    G_STAGE(G_SB(0, 0), cB, voffB); G_STAGE(G_SA(0, 0), cA, voffA); G_STAGE(G_SB(0, 1), cB + hstepB, voffB); G_STAGE(G_SA(0, 1), cA + hstepA, voffA);
    if (wr == 1) G_BAR;
    G_WAIT_V(4); G_BAR;
    G_STAGE(G_SB(1, 0), cB + kstep, voffB); G_STAGE(G_SA(1, 0), cA + kstep, voffA); G_STAGE(G_SB(1, 1), cB + hstepB + kstep, voffB);
    G_WAIT_V(6); G_BAR;
    for (;;) {
        const bool has_next = unit_next(g, ui + 1, nxt);
        const char* nA = has_next ? (const char*)(g.A + (size_t)nxt.pb * g.strideA) + (size_t)nxt.pm * 2 * hstepA : cA;
        const char* nB = has_next ? (const char*)(g.Bt + (size_t)nxt.pb * g.strideB) + (size_t)nxt.pn * 2 * hstepB : cB;
        for (int t = 0; t < nt; t += 2) {
            const bool last = (t == nt - 2);
            const char* a1 = cA + (size_t)(t + 1) * kstep;
            const char* a2 = last ? nA : cA + (size_t)(t + 2) * kstep; const char* b2 = last ? nB : cB + (size_t)(t + 2) * kstep;
            const char* a3 = a2 + kstep; const char* b3 = b2 + kstep;
            G_LDB(B0, 0, 0); G_SCHED; G_LDA(At, 0, 0); G_STAGE(G_SA(1, 1), a1 + hstepA, voffA);
            G_WAIT_L(8); G_BAR; G_WAIT_L(0); G_MMA(0, 0, At, B0); G_BAR; G_SCHED;
            G_LDB(B1, 0, 1); G_STAGE(G_SB(0, 0), b2, voffB);
            G_BAR; G_WAIT_L(0); G_MMA(0, 1, At, B1); G_BAR;
            G_LDA(At, 0, 1); G_STAGE(G_SA(0, 0), a2, voffA);
            G_BAR; G_WAIT_L(0); G_MMA(1, 0, At, B0); G_BAR; G_SCHED;
            G_STAGE(G_SB(0, 1), b2 + hstepB, voffB);
            G_WAIT_V(6); G_BAR; G_MMA(1, 1, At, B1); G_BAR;
            G_LDB(B0, 1, 0); G_SCHED; G_LDA(At, 1, 0); G_STAGE(G_SA(0, 1), a2 + hstepA, voffA);
            G_WAIT_L(8); G_BAR; G_WAIT_L(0); G_MMA(0, 0, At, B0); G_BAR; G_SCHED;
            G_LDB(B1, 1, 1); G_STAGE(G_SB(1, 0), b3, voffB);
            G_BAR; G_WAIT_L(0); G_MMA(0, 1, At, B1); G_BAR;
            G_LDA(At, 1, 1); G_STAGE(G_SA(1, 0), a3, voffA);
            G_BAR; G_WAIT_L(0); G_MMA(1, 0, At, B0); G_BAR; G_SCHED;
            G_STAGE(G_SB(1, 1), b3 + hstepB, voffB);
            G_WAIT_V(6); G_BAR; G_MMA(1, 1, At, B1); G_BAR;
        }
        epilogue<MODE>(acc, cur, E, wr, wc, fr, fq);
        if (!has_next) break;
#pragma unroll
        for (int a = 0; a < 2; ++a)
#pragma unroll
            for (int b = 0; b < 2; ++b)
#pragma unroll
                for (int m = 0; m < 4; ++m)
#pragma unroll
                    for (int n = 0; n < 2; ++n) acc[a][b][m][n] = (f32x4){0.f, 0.f, 0.f, 0.f};
        cur = nxt; cA = nA; cB = nB; ++ui;
    }
    G_WAIT_V(0);
    if (wr == 0) G_BAR;
    G_BAR;
#undef G_SA
#undef G_SB
#undef G_STAGE
#undef G_LDA
#undef G_LDB
#undef G_MMA
#undef G_WAIT_V
#undef G_WAIT_L
#undef G_BAR
#undef G_SCHED
}

__device__ __forceinline__ void tr_tile(const float* src, int N, int ldsrc, h16* dst, int lddst, int mode, int kb, int nb, float* scr) {
    const int t = threadIdx.x, k0 = kb * 64, n0 = nb * 64;
    { const int nl = t & 63, kl0 = t >> 6;
#pragma unroll
      for (int i = 0; i < 8; ++i) { const int kl = kl0 + 8 * i; scr[kl * 65 + nl] = (n0 + nl < N) ? src[(size_t)(k0 + kl) * ldsrc + n0 + nl] : 0.f; } }
    __syncthreads();
    { const int kp = t & 31, nl0 = t >> 5;
#pragma unroll
      for (int i = 0; i < 4; ++i) { const int nl = nl0 + 16 * i, n = n0 + nl;
          const int row = mode == 0 ? n : ((n >> 4) * 32 + (mode == 2 ? 16 : 0) + (n & 15));
          h16x2 v; v.x = (h16)scr[(2 * kp) * 65 + nl]; v.y = (h16)scr[(2 * kp + 1) * 65 + nl];
          *(h16x2*)(dst + (size_t)row * lddst + k0 + 2 * kp) = v; } }
    __syncthreads();
}

__device__ __forceinline__ void prep_transposes(const Params& P, float* scr) {
    unsigned char* ws = P.ws;
    constexpr int T_FFN = 704, N_FFN = 24 * T_FFN, T_PP = 64, T_SQ = 256, T_ABIN = 512, T_GLU = 64, T_CIN = 576;
    constexpr int TOTAL = N_FFN + 4 * T_PP + 4 * T_SQ + 2 * T_ABIN + 2 * T_SQ + 2 * T_GLU + 2 * T_CIN + 2 * T_SQ;
    constexpr int T1 = 12160;
    const int nb2 = (int)gridDim.x > 64 ? (int)gridDim.x - 64 : (int)gridDim.x;
    for (int it0 = blockIdx.x; ; ) {
        int it;
        if (it0 < T1) { it = it0; it0 += gridDim.x; if (it0 >= T1) it0 = (blockIdx.x >= 64 || gridDim.x <= 64) ? T1 + ((int)blockIdx.x >= 64 ? (int)blockIdx.x - 64 : (int)blockIdx.x) : TOTAL; }
        else { it = it0; it0 += nb2; }
        if (it >= TOTAL) break;
        int r = it;
        if (r < N_FFN) { const int mtx = r / T_FFN, tl = r % T_FFN, which = mtx / 8, li = mtx % 8;
            if (which == 0) tr_tile(P.w1 + (size_t)li * 1024 * 2816, 2816, 2816, (h16*)(ws + OFF_W13 + li * SZ_W13), 1024, 1, tl / 44, tl % 44, scr);
            else if (which == 1) tr_tile(P.w3 + (size_t)li * 1024 * 2816, 2816, 2816, (h16*)(ws + OFF_W13 + li * SZ_W13), 1024, 2, tl / 44, tl % 44, scr);
            else tr_tile(P.w2 + (size_t)li * 2816 * 1024, 1024, 1024, (h16*)(ws + OFF_W2T + li * SZ_W2T), 2816, 0, tl / 16, tl % 16, scr);
            continue; } r -= N_FFN;
        if (r < 4 * T_PP) { const int i = r / T_PP, tl = r % T_PP; tr_tile(P.plep + (size_t)i * 256 * 1024, 1024, 1024, (h16*)(ws + OFF_WPT + i * SZ_WPT), 256, 0, tl / 16, tl % 16, scr); continue; } r -= 4 * T_PP;
        if (r < 4 * T_SQ) { const int i = r / T_SQ, tl = r % T_SQ; tr_tile(P.pleg + (size_t)i * 1024 * 1024, 1024, 1024, (h16*)(ws + OFF_WGT + i * SZ_SQ), 1024, 0, tl / 16, tl % 16, scr); continue; } r -= 4 * T_SQ;
        if (r < 2 * T_ABIN) { const int i = r / T_ABIN, tl = r % T_ABIN; tr_tile(P.abin + (size_t)i * 1024 * 2048, 2048, 2048, (h16*)(ws + OFF_ABIN + i * SZ_ABIN), 1024, 0, tl / 32, tl % 32, scr); continue; } r -= 2 * T_ABIN;
        if (r < 2 * T_SQ) { const int i = r / T_SQ, tl = r % T_SQ; tr_tile(P.about + (size_t)i * 1024 * 1024, 1024, 1024, (h16*)(ws + OFF_ABOUT + i * SZ_SQ), 1024, 0, tl / 16, tl % 16, scr); continue; } r -= 2 * T_SQ;
        if (r < 2 * T_GLU) { const int i = r / T_GLU, tl = r % T_GLU; tr_tile(P.wglu + (size_t)i * 512 * 512, 512, 512, (h16*)(ws + OFF_WGLU + i * SZ_WGLU), 512, 0, tl / 8, tl % 8, scr); continue; } r -= 2 * T_GLU;
        if (r < 2 * T_CIN) { const int i = r / T_CIN, tl = r % T_CIN; tr_tile(P.cin + (size_t)i * 1024 * 2120, 2120, 2120, (h16*)(ws + OFF_CIN + i * SZ_CIN), 1024, 0, tl / 36, tl % 36, scr); continue; } r -= 2 * T_CIN;
        { const int i = r / T_SQ, tl = r % T_SQ; tr_tile(P.cout + (size_t)i * 1024 * 1024, 1024, 1024, (h16*)(ws + OFF_COUT + i * SZ_SQ), 1024, 0, tl / 16, tl % 16, scr); }
    }
}

__device__ __forceinline__ void s5_build(const Params& P, int j, int g, float* L) {
    float* abr = L;
    float* abi = L + 2112;
    float* bbr = L + 4224;
    float* bbi = L + 5248;
    float* ccr = L + 6272;
    float* cci = L + 7296;
    float* fre = L + 8320;
    float* fim = L + 8384;
    float* Kt = L + 8448;
    const int tid = threadIdx.x, jg = j * 32 + g;
    if (tid < 64) {
        const int p = tid;
        const float lr = fminf(P.lamre[jg * 64 + p], -1e-4f), li = P.lamim[jg * 64 + p], dt = expf(P.logdt[jg]);
        const float mag = expf(lr * dt), are = mag * cosf(li * dt), aim = mag * sinf(li * dt);
        const float nr = are - 1.f, ni = aim, den = lr * lr + li * li;
        fre[p] = (nr * lr + ni * li) / den; fim[p] = (ni * lr - nr * li) / den;
        float pr = 1.f, pi = 0.f;
        for (int d = 0; d <= 32; ++d) { abr[d * 64 + p] = pr; abi[d * 64 + p] = pi; const float t = pr * are - pi * aim; pi = pr * aim + pi * are; pr = t; }
    }
    __syncthreads();
    for (int e = tid; e < 1024; e += 512) {
        const int p = e >> 4;
        const float br = P.bre[(size_t)jg * 1024 + e], bi = P.bim[(size_t)jg * 1024 + e];
        bbr[e] = fre[p] * br - fim[p] * bi; bbi[e] = fre[p] * bi + fim[p] * br;
        ccr[e] = P.cre[(size_t)jg * 1024 + e]; cci[e] = P.cim[(size_t)jg * 1024 + e];
    }
    __syncthreads();
    for (int e = tid; e < 8192; e += 512) {
        const int d = e >> 8, co = (e >> 4) & 15, ci = e & 15; float s = 0.f;
        for (int p = 0; p < 64; ++p) {
            const float ar = abr[d * 64 + p], ai = abi[d * 64 + p], br = bbr[p * 16 + ci], bi = bbi[p * 16 + ci];
            const float wr_ = ar * br - ai * bi, wi_ = ar * bi + ai * br;
            s += ccr[co * 64 + p] * wr_ - cci[co * 64 + p] * wi_;
        }
        Kt[e] = s * 1024.f;
    }
    __syncthreads();
    h16* W1 = (h16*)(P.ws + OFF_W1M + (size_t)j * SZ_W1M) + (size_t)g * 256 * 512;
    for (int e = tid; e < 128 * 256; e += 512) {
        const int n = e >> 8, k = (e & 255) * 2, tau = k >> 4, ci = k & 15, p = n & 63, d = 31 - tau;
        const float ar = abr[d * 64 + p], ai = abi[d * 64 + p]; h16x2 v;
        if (n < 64) { v.x = (h16)(1024.f * (ar * bbr[p * 16 + ci] - ai * bbi[p * 16 + ci])); v.y = (h16)(1024.f * (ar * bbr[p * 16 + ci + 1] - ai * bbi[p * 16 + ci + 1])); }
        else { v.x = (h16)(1024.f * (ar * bbi[p * 16 + ci] + ai * bbr[p * 16 + ci])); v.y = (h16)(1024.f * (ar * bbi[p * 16 + ci + 1] + ai * bbr[p * 16 + ci + 1])); }
        *(h16x2*)(W1 + (size_t)n * 512 + k) = v;
        h16x2 z; z.x = (h16)0.f; z.y = (h16)0.f; *(h16x2*)(W1 + (size_t)(128 + n) * 512 + k) = z;
    }
    h16* M2 = (h16*)(P.ws + OFF_M2 + (size_t)j * SZ_M2) + (size_t)g * 512 * 640;
    for (int e = tid; e < 512 * 320; e += 512) {
        const int n = e / 320, k = (e % 320) * 2, t = n >> 4, co = n & 15; h16x2 v;
        if (k < 512) { const int tau = k >> 4, ci = k & 15;
            if (tau <= t) { v.x = (h16)Kt[(t - tau) * 256 + co * 16 + ci]; v.y = (h16)Kt[(t - tau) * 256 + co * 16 + ci + 1]; } else { v.x = (h16)0.f; v.y = (h16)0.f; } }
        else if (k < 576) { const int p = k - 512;
            v.x = (h16)(ccr[co * 64 + p] * abr[(t + 1) * 64 + p] - cci[co * 64 + p] * abi[(t + 1) * 64 + p]);
            v.y = (h16)(ccr[co * 64 + p + 1] * abr[(t + 1) * 64 + p + 1] - cci[co * 64 + p + 1] * abi[(t + 1) * 64 + p + 1]); }
        else { const int p = k - 576;
            v.x = (h16)(-(ccr[co * 64 + p] * abi[(t + 1) * 64 + p] + cci[co * 64 + p] * abr[(t + 1) * 64 + p]));
            v.y = (h16)(-(ccr[co * 64 + p + 1] * abi[(t + 1) * 64 + p + 1] + cci[co * 64 + p + 1] * abr[(t + 1) * 64 + p + 1])); }
        *(h16x2*)(M2 + (size_t)n * 640 + k) = v;
    }
    if (tid < 64) { f32x2 a; a.x = abr[32 * 64 + tid]; a.y = abi[32 * 64 + tid]; *(f32x2*)(P.ws + OFF_A32 + ((size_t)jg * 64 + tid) * 8) = a; }
    __syncthreads();
}

__device__ __forceinline__ void ln_pass(h16* Y16, const float* g, const float* b) {
    int tid_ = threadIdx.x; asm volatile("" : "+v"(tid_));
    const int lane = tid_ & 63, wave = tid_ >> 6;
    f32x4 gv[4], bv[4];
#pragma unroll
    for (int j = 0; j < 2; ++j)
#pragma unroll
        for (int q = 0; q < 2; ++q) { gv[2 * j + q] = *(const f32x4*)(g + 8 * lane + 512 * j + 4 * q); bv[2 * j + q] = *(const f32x4*)(b + 8 * lane + 512 * j + 4 * q); }
    for (int row0 = (blockIdx.x * 8 + wave) * 4; row0 < NTOK; row0 += gridDim.x * 32) {
        h16x8 w[4][2];
#pragma unroll
        for (int r = 0; r < 4; ++r)
#pragma unroll
            for (int j = 0; j < 2; ++j) w[r][j] = *(const h16x8*)(Y16 + (size_t)(row0 + r) * DM + 8 * lane + 512 * j);
#pragma unroll
        for (int r = 0; r < 4; ++r) {
            h16* yr = Y16 + (size_t)(row0 + r) * DM + 8 * lane; f32x4 v[4]; float s = 0.f;
#pragma unroll
            for (int j = 0; j < 2; ++j) {
                v[2 * j] = (f32x4){(float)w[r][j][0], (float)w[r][j][1], (float)w[r][j][2], (float)w[r][j][3]}; v[2 * j + 1] = (f32x4){(float)w[r][j][4], (float)w[r][j][5], (float)w[r][j][6], (float)w[r][j][7]}; }
#pragma unroll
            for (int j = 0; j < 4; ++j) s += (v[j].x + v[j].y) + (v[j].z + v[j].w);
            const float mean = wave_sum(s) * (1.f / DM); float s2 = 0.f;
#pragma unroll
            for (int j = 0; j < 4; ++j) { v[j] = v[j] - mean; s2 += (v[j].x * v[j].x + v[j].y * v[j].y) + (v[j].z * v[j].z + v[j].w * v[j].w); }
            const float rstd = 1.f / sqrtf(wave_sum(s2) * (1.f / DM) + LN_EPS);
#pragma unroll
            for (int j = 0; j < 2; ++j) { const f32x4 o0 = v[2 * j] * rstd * gv[2 * j] + bv[2 * j], o1 = v[2 * j + 1] * rstd * gv[2 * j + 1] + bv[2 * j + 1]; h16x8 o;
                o[0] = (h16)o0.x; o[1] = (h16)o0.y; o[2] = (h16)o0.z; o[3] = (h16)o0.w; o[4] = (h16)o1.x; o[5] = (h16)o1.y; o[6] = (h16)o1.z; o[7] = (h16)o1.w;
                *(h16x8*)(yr + 512 * j) = o; }
        }
    }
}

__device__ __forceinline__ void cvt_pass(const float* src, h16* dst, size_t n, float* dup) {
    for (size_t i = ((size_t)blockIdx.x * 512 + threadIdx.x) * 8; i < n; i += (size_t)gridDim.x * 512 * 8) {
        const f32x4 a = *(const f32x4*)(src + i), b = *(const f32x4*)(src + i + 4);
        h16x8 o; o[0] = (h16)a.x; o[1] = (h16)a.y; o[2] = (h16)a.z; o[3] = (h16)a.w; o[4] = (h16)b.x; o[5] = (h16)b.y; o[6] = (h16)b.z; o[7] = (h16)b.w;
        *(h16x8*)(dst + i) = o;
        if (dup) { *(f32x4*)(dup + i) = a; *(f32x4*)(dup + i + 4) = b; }
    }
}

__device__ __forceinline__ void conv_pass(const h16* PE, const float* cw, h16* MIXA) {
    for (size_t i = (size_t)blockIdx.x * 512 + threadIdx.x; i < (size_t)NTOK * 64; i += (size_t)gridDim.x * 512) {
        const int row = (int)(i >> 6), c = (int)(i & 63) * 8, l = row & (SEQ - 1);
        const h16* pr = PE + (size_t)row * 1536 + c;
        const h16x8 h0 = *(const h16x8*)pr, gb = *(const h16x8*)(pr + 512), g0 = *(const h16x8*)(pr + 1024);
        h16x8 h1, g1, h2, g2;
        if (l >= 1) { h1 = *(const h16x8*)(pr - 1536); g1 = *(const h16x8*)(pr - 1536 + 1024); }
        if (l >= 2) { h2 = *(const h16x8*)(pr - 3072); g2 = *(const h16x8*)(pr - 3072 + 1024); }
        h16x8 o;
#pragma unroll
        for (int e = 0; e < 8; ++e) {
            float v = cw[1024 + c + e] * ((float)g0[e] * (float)h0[e]);
            if (l >= 1) v += cw[512 + c + e] * ((float)g1[e] * (float)h1[e]);
            if (l >= 2) v += cw[c + e] * ((float)g2[e] * (float)h2[e]);
            o[e] = (h16)((float)gb[e] * v);
        }
        *(h16x8*)(MIXA + (size_t)row * DM + c) = o;
    }
}
__device__ __forceinline__ void carry_unit(const float* SLOC, h16* UG, const float* A32, unsigned char* shm, int b, int g) {
    int tid_ = threadIdx.x; asm volatile("" : "+v"(tid_));
    const int p = tid_ & 63, seg = tid_ >> 6;
    f32x2* segE = (f32x2*)shm;
    f32x2* segS = (f32x2*)(shm + 4096);
    const f32x2 a = *(const f32x2*)(A32 + ((size_t)g * 64 + p) * 2);
    const size_t row0 = (size_t)g * 1024 + b * 256 + seg * 32;
    float sr = 0.f, si = 0.f;
    for (int k0 = 0; k0 < 32; k0 += 4) {
        float xr[4], xi[4];
#pragma unroll
        for (int k = 0; k < 4; ++k) { xr[k] = SLOC[(row0 + k0 + k) * 128 + p]; xi[k] = SLOC[(row0 + k0 + k) * 128 + 64 + p]; }
#pragma unroll
        for (int k = 0; k < 4; ++k) { const float t = a.x * sr - a.y * si + xr[k]; si = a.x * si + a.y * sr + xi[k]; sr = t; }
    }
    { f32x2 e; e.x = sr; e.y = si; segE[seg * 64 + p] = e; }
    __syncthreads();
    if (seg == 0) {
        float mr = a.x, mi = a.y;
#pragma unroll
        for (int q = 0; q < 5; ++q) { const float t = mr * mr - mi * mi; mi = 2.f * mr * mi; mr = t; }
        float cr = 0.f, ci = 0.f;
#pragma unroll
        for (int s = 0; s < 8; ++s) { f32x2 st; st.x = cr; st.y = ci; segS[s * 64 + p] = st; const f32x2 e = segE[s * 64 + p];
            const float t = mr * cr - mi * ci + e.x; ci = mr * ci + mi * cr + e.y; cr = t; }
    }
    __syncthreads();
    { const f32x2 st = segS[seg * 64 + p]; sr = st.x; si = st.y; }
    for (int k0 = 0; k0 < 32; k0 += 4) {
        float xr[4], xi[4];
#pragma unroll
        for (int k = 0; k < 4; ++k) { xr[k] = SLOC[(row0 + k0 + k) * 128 + p]; xi[k] = SLOC[(row0 + k0 + k) * 128 + 64 + p]; }
#pragma unroll
        for (int k = 0; k < 4; ++k) {
            h16* ur = UG + (row0 + k0 + k) * 640 + 512 + p; ur[0] = (h16)(sr * 1024.f); ur[64] = (h16)(si * 1024.f);
            const float t = a.x * sr - a.y * si + xr[k]; si = a.x * si + a.y * sr + xi[k]; sr = t;
        }
    }
    __syncthreads();
}

#define XB_TMO      128
#define XB_XCNT(j)  (256  + 64 * (j))
#define XB_XSUB(j)  (1280 + 64 * (j))
#define XB_XGEN(j)  (2304 + 64 * (j))
#define XB_TOP      3328
#define XB_TOPGEN   3392
#define XCD_BAR_WORDS 3456
#define XB_SPIN_CAP (1u << 22)
__device__ __forceinline__ unsigned xb_ld(unsigned* p)              { return __hip_atomic_load(p, __ATOMIC_RELAXED, __HIP_MEMORY_SCOPE_AGENT); }
__device__ __forceinline__ unsigned xb_add(unsigned* p, unsigned v) { return __hip_atomic_fetch_add(p, v, __ATOMIC_RELAXED, __HIP_MEMORY_SCOPE_AGENT); }
__device__ __forceinline__ unsigned xb_xcc_id() { return (unsigned)__builtin_amdgcn_s_getreg((3 << 11) | 20) & 0xFu; }
#define XB_SPIN(cond, bar) do { unsigned _sp = 0; while (cond) { __builtin_amdgcn_s_sleep(1); \
    if ((++_sp & 255u) == 0u) { if (xb_ld(&(bar)[XB_TMO])) break; if (_sp > XB_SPIN_CAP) { atomicAdd(&(bar)[XB_TMO], 1u); break; } } } } while (0)
__device__ __forceinline__ void xcd_barrier_complete(unsigned* bar, unsigned x, unsigned& nloc, unsigned& nx) {
    const unsigned G = gridDim.x;
    unsigned sum, cnt, mine, sp = 0u;
    for (;;) {
        sum = 0u; cnt = 0u; mine = 0u;
#pragma unroll
        for (unsigned j = 0; j < 16; ++j) { const unsigned c = xb_ld(&bar[XB_XCNT(j)]); sum += c; cnt += (c > 0u) ? 1u : 0u; mine = (j == x) ? c : mine; }
        if (sum == G) break;
        __builtin_amdgcn_s_sleep(1);
        if ((++sp & 255u) == 0u) { if (xb_ld(&bar[XB_TMO])) break; if (sp > XB_SPIN_CAP) { atomicAdd(&bar[XB_TMO], 1u); break; } }
    }
    nloc = mine > 0u ? mine : 1u; nx = cnt > 0u ? cnt : 1u;
}
__device__ __forceinline__ void xcd_barrier(unsigned* bar, volatile LAS unsigned* st) {
    asm volatile("s_waitcnt vmcnt(0)" ::: "memory");
    __syncthreads();
    if (threadIdx.x == 0) {
        const unsigned x = xb_xcc_id();
        __builtin_amdgcn_s_waitcnt(0);
        unsigned nloc = st[0], nx = st[1];
        if (nloc == 0u) { xcd_barrier_complete(bar, x, nloc, nx); st[0] = nloc; st[1] = nx; }
        const unsigned old = xb_add(&bar[XB_XSUB(x)], 1u);
        const unsigned gen = old / nloc;
        if (old + 1u == (gen + 1u) * nloc) {
            __builtin_amdgcn_fence(__ATOMIC_RELEASE, "agent");
            asm volatile("s_waitcnt vmcnt(0)" ::: "memory");
            const unsigned og = xb_add(&bar[XB_TOP], 1u);
            const unsigned tg = og / nx;
            if (og + 1u == (tg + 1u) * nx) xb_add(&bar[XB_TOPGEN], 1u);
            else XB_SPIN(xb_ld(&bar[XB_TOPGEN]) == tg, bar);
            __builtin_amdgcn_fence(__ATOMIC_ACQUIRE, "agent");
            xb_add(&bar[XB_XGEN(x)], 1u);
            asm volatile("s_waitcnt vmcnt(0)" ::: "memory");
        } else {
            XB_SPIN(xb_ld(&bar[XB_XGEN(x)]) == gen, bar);
            __builtin_amdgcn_fence(__ATOMIC_ACQUIRE, "agent");
            asm volatile("s_waitcnt vmcnt(0)" ::: "memory");
        }
    }
    __syncthreads();
}

__device__ __forceinline__ bool xcd_unit_rank(unsigned* bar, unsigned x, unsigned r, int U, int u, int& rank, int& total) {
    unsigned c[16];
#pragma unroll
    for (int j = 0; j < 16; ++j) c[j] = xb_ld(&bar[XB_XCNT(j)]);
    int nx = 0, myo = 0;
#pragma unroll
    for (int j = 0; j < 16; ++j) if (c[j]) { if ((unsigned)j < x) ++myo; ++nx; }
    const int m = nx < U ? nx : U, um = u % m;
    if (myo % m != um) return false;
    int ord = 0; rank = (int)r; total = 0;
#pragma unroll
    for (int j = 0; j < 16; ++j) if (c[j]) { if (ord % m == um) { total += (int)c[j]; if ((unsigned)j < x) rank += (int)c[j]; } ++ord; }
    return true;
}

template <int PASS>
__device__ __forceinline__ void idx_tiles(const unsigned char* buf, int Tbase, int tq, int fr, int fq, const h16x8 (&aq)[2][2], const float (&wv)[8], const h16x2 (&wp)[4],
                                          unsigned* myhist, unsigned b0, unsigned* myctl, unsigned* mycand, unsigned short* out) {
    const int sw = (fr >> 1) & 7;
    const unsigned char* lp = buf + fr * 128;
#pragma unroll
    for (int hb = 0; hb < 2; ++hb) {
        h16x8 kf[8][2];
#pragma unroll
        for (int e = 0; e < 8; ++e) { const unsigned char* tp = lp + (hb * 8 + e) * 2048; kf[e][0] = *(const h16x8*)(tp + ((fq ^ sw) << 4)); kf[e][1] = *(const h16x8*)(tp + (((fq + 4) ^ sw) << 4)); }
#pragma unroll
        for (int e = 0; e < 8; ++e) { const int T = Tbase + hb * 8 + e;
            f32x4 a0 = (f32x4){0.f, 0.f, 0.f, 0.f}, a1 = a0;
            a0 = __builtin_amdgcn_mfma_f32_16x16x32_f16(aq[0][0], kf[e][0], a0, 0, 0, 0); a0 = __builtin_amdgcn_mfma_f32_16x16x32_f16(aq[0][1], kf[e][1], a0, 0, 0, 0);
            a1 = __builtin_amdgcn_mfma_f32_16x16x32_f16(aq[1][0], kf[e][0], a1, 0, 0, 0); a1 = __builtin_amdgcn_mfma_f32_16x16x32_f16(aq[1][1], kf[e][1], a1, 0, 0, 0);
            const h16x2 z2 = (h16x2){(h16)0.f, (h16)0.f};
            const h16x2 r0 = __builtin_elementwise_max(__builtin_bit_cast(h16x2, __builtin_amdgcn_cvt_pkrtz(a0[0], a0[1])), z2), r1 = __builtin_elementwise_max(__builtin_bit_cast(h16x2, __builtin_amdgcn_cvt_pkrtz(a0[2], a0[3])), z2);
            const h16x2 r2 = __builtin_elementwise_max(__builtin_bit_cast(h16x2, __builtin_amdgcn_cvt_pkrtz(a1[0], a1[1])), z2), r3 = __builtin_elementwise_max(__builtin_bit_cast(h16x2, __builtin_amdgcn_cvt_pkrtz(a1[2], a1[3])), z2);
            const float sa = __builtin_amdgcn_fdot2(r0, wp[0], __builtin_amdgcn_fdot2(r1, wp[1], __builtin_amdgcn_fdot2(r2, wp[2], __builtin_amdgcn_fdot2(r3, wp[3], 0.f, false), false), false), false);
            const int key = 16 * T + fr;
            if (key <= tq) {
                const unsigned bin = (unsigned)(int)fminf(fmaxf(sa * 32.f + 128.f, 0.f), 255.f);
                if (PASS == 1) { if (bin >= b0) atomicAdd(&myhist[fq * 256 + bin], 1u); }
                else {
                    if (bin > b0) { const unsigned pos = atomicAdd(&myctl[fq * 4 + 2], 1u); ((unsigned short*)myhist)[fq * 256 + (pos & 255u)] = (unsigned short)key; }
                    else if (bin == b0) { const unsigned c = atomicAdd(&myctl[fq * 4 + 3], 1u);
                        if (c < 128u) { float s = 0.f;
#pragma unroll
                            for (int r = 0; r < 4; ++r) s += wv[r] * fmaxf(a0[r], 0.f) + wv[4 + r] * fmaxf(a1[r], 0.f);
                            s = fminf(fmaxf(s, -3.99f), 3.99f);
                            mycand[(fq * 128 + c) * 2] = (unsigned)((s + 4.f) * 536870912.f); mycand[(fq * 128 + c) * 2 + 1] = (unsigned)key; } }
                }
            }
        }
        __builtin_amdgcn_sched_barrier(0);
    }
}
template <int PASS, bool SAMPLE>
__device__ __forceinline__ void idx_sweep(const h16* KIb, int nch, unsigned char* stage, int tid, int tq, int fr, int fq, const h16x8 (&aq)[2][2], const float (&wv)[8], const h16x2 (&wp)[4],
                                          unsigned* myhist, unsigned b0, unsigned* myctl, unsigned* mycand, unsigned short* out) {
    int loff[4];
#pragma unroll
    for (int i = 0; i < 4; ++i) { const int o = (tid + 512 * i) * 16, R = o >> 7, c16 = (o >> 4) & 7, r = R & 15; loff[i] = (R >> 4) * 2048 + r * 128 + ((c16 ^ ((r >> 1) & 7)) << 4); }
    const unsigned char* src = (const unsigned char*)KIb + tid * 16;
    h16x8 st[4];
    const int rot = (int)((blockIdx.x * 7u) % (unsigned)nch);
#pragma unroll
    for (int i = 0; i < 4; ++i) st[i] = *(const h16x8*)(src + (size_t)rot * 32768 + 8192 * i);
#pragma unroll
    for (int i = 0; i < 4; ++i) *(h16x8*)(stage + loff[i]) = st[i];
    __syncthreads();
    for (int c = 0; c < nch; ++c) {
        const bool more = (c + 1) < nch;
        int cc = c + rot; cc = cc >= nch ? cc - nch : cc;
        int cn = cc + 1; cn = cn >= nch ? 0 : cn;
        if (more) {
#pragma unroll
            for (int i = 0; i < 4; ++i) st[i] = *(const h16x8*)(src + (size_t)cn * 32768 + 8192 * i); }
        idx_tiles<PASS>(stage + (c & 1) * 32768, cc * 16, tq, fr, fq, aq, wv, wp, myhist, b0, myctl, mycand, out);
        if (PASS == 1 && SAMPLE && c == 1 && nch > 2) {
            asm volatile("s_waitcnt lgkmcnt(0)" ::: "memory");
            const unsigned want = (unsigned)((tq + 1) < 256 ? (tq + 1) : 256);
            unsigned cnt[16]; unsigned lsum = 0u;
#pragma unroll
            for (int i = 0; i < 16; ++i) { cnt[i] = myhist[fq * 256 + fr * 16 + i]; lsum += cnt[i]; }
            unsigned incl = lsum;
#pragma unroll
            for (int o = 1; o < 16; o <<= 1) { const unsigned v = __shfl_down(incl, o); if (fr + o < 16) incl += v; }
            const unsigned ns = __shfl(incl, fq * 16);
            const unsigned target = (unsigned)(2.f * (float)want * (float)ns / (float)(tq + 1)) + 10u;
            const unsigned above = incl - lsum;
            if (fr == 0) myctl[fq * 4] = 0u;
            asm volatile("s_waitcnt lgkmcnt(0)" ::: "memory");
            if (target < ns && above < target && target <= incl) { unsigned cum = above; int bin = 0; bool found = false;
#pragma unroll
                for (int i = 15; i >= 0; --i) { if (!found) { if (cum + cnt[i] >= target) { bin = i; found = true; } else cum += cnt[i]; } }
                myctl[fq * 4] = (unsigned)(fr * 16 + bin); }
            asm volatile("s_waitcnt lgkmcnt(0)" ::: "memory");
            const unsigned fb = myctl[fq * 4];
            b0 = fb > 0u ? fb - 1u : 0u;
            if (fr == 0) myctl[fq * 4 + 1] = b0;
        }
        if (more) {
#pragma unroll
            for (int i = 0; i < 4; ++i) *(h16x8*)(stage + ((c + 1) & 1) * 32768 + loff[i]) = st[i]; }
        __syncthreads();
    }
}

__device__ __forceinline__ void dsa_select(const h16* PROJ, unsigned short* IDX, int* CNT, unsigned char* shm, unsigned* bar, unsigned xcc, unsigned xrank) {
    int tid_ = threadIdx.x; asm volatile("" : "+v"(tid_));
    const int tid = tid_, wid = tid >> 6, lane = tid & 63, fr = lane & 15, fq = lane >> 4;
    unsigned char* stage = shm;
    unsigned* myhist = (unsigned*)(shm + 65536) + wid * 1024;
    unsigned* mycand = (unsigned*)(shm + 98304) + wid * 1024;
    unsigned* myctl = (unsigned*)(shm + 131072) + wid * 16;
    for (int b = 0; b < NBATCH; ++b) {
        int rank, total; if (!xcd_unit_rank(bar, xcc, xrank, NBATCH, b, rank, total)) continue;
        const int nrounds = (256 + total - 1) / total;
        const h16* KIb = PROJ + O_KI + (size_t)b * SEQ * 64;
        for (int k = 0; k < nrounds; ++k) {
            const int it = k * total + ((k & 1) ? (total - 1 - rank) : rank);
            if (it >= 256) continue;
            const int tokbase = b * SEQ, t0 = it * 32 + wid * 4, tq = t0 + fq;
            const int nch = ((it * 32 + 31) / 16 + 1 + 15) / 16;
#pragma unroll
            for (int i = 0; i < 16; ++i) myhist[lane + 64 * i] = 0u;
            if (lane < 16) myctl[lane] = 0u;
            h16x8 aq[2][2];
            { const h16* qrow = PROJ + O_QI + (size_t)(tokbase + t0 + (fr >> 2)) * 512 + (fr & 3) * 64 + 8 * fq;
#pragma unroll
              for (int hh = 0; hh < 2; ++hh)
#pragma unroll
                  for (int kk = 0; kk < 2; ++kk) aq[hh][kk] = *(const h16x8*)(qrow + hh * 256 + kk * 32); }
            float wv[8];
            { const h16x8 w8 = *(const h16x8*)(PROJ + O_WI + (size_t)(tokbase + tq) * 8);
#pragma unroll
              for (int h = 0; h < 8; ++h) wv[h] = (float)w8[h] * 0.04419417382415922f; }
            h16x2 wp[4];
#pragma unroll
            for (int h = 0; h < 4; ++h) { wp[h].x = (h16)wv[(h >> 1) * 4 + (h & 1) * 2]; wp[h].y = (h16)wv[(h >> 1) * 4 + (h & 1) * 2 + 1]; }
            __builtin_amdgcn_s_waitcnt(0);
            unsigned short* out = IDX + (size_t)(tokbase + tq) * 256;
            unsigned* blkflag = (unsigned*)(shm + 131072 + 1024);
            if (tid == 0) *blkflag = 0u;
            idx_sweep<1, true>(KIb, nch, stage, tid, tq, fr, fq, aq, wv, wp, myhist, 0u, myctl, mycand, out);
            {
                unsigned tot = 0u; const unsigned flo = myctl[fq * 4 + 1];
#pragma unroll
                for (int i = 0; i < 16; ++i) { const unsigned cb = myhist[fq * 256 + fr * 16 + i]; tot += ((unsigned)(fr * 16 + i) >= flo) ? cb : 0u; }
#pragma unroll
                for (int o = 1; o < 16; o <<= 1) tot += __shfl_xor(tot, o);
                const unsigned want0 = (unsigned)((tq + 1) < 256 ? (tq + 1) : 256);
                if (tot < want0) *blkflag = 1u;
                __syncthreads();
                if (*blkflag != 0u) {
#pragma unroll
                    for (int i = 0; i < 16; ++i) myhist[lane + 64 * i] = 0u;
                    asm volatile("s_waitcnt lgkmcnt(0)" ::: "memory");
                    idx_sweep<1, false>(KIb, nch, stage, tid, tq, fr, fq, aq, wv, wp, myhist, 0u, myctl, mycand, out);
                }
            }
            { const unsigned want = (unsigned)((tq + 1) < 256 ? (tq + 1) : 256);
              unsigned c[16]; unsigned lsum = 0u;
#pragma unroll
              for (int i = 0; i < 16; ++i) { c[i] = myhist[fq * 256 + fr * 16 + i]; lsum += c[i]; }
              unsigned incl = lsum;
#pragma unroll
              for (int o = 1; o < 16; o <<= 1) { const unsigned v = __shfl_down(incl, o); if (fr + o < 16) incl += v; }
              const unsigned above = incl - lsum;
              if (above < want && want <= incl) { unsigned cum = above; int bin = 0; bool found = false;
#pragma unroll
                  for (int i = 15; i >= 0; --i) { if (!found) { if (cum + c[i] >= want) { bin = i; found = true; } else cum += c[i]; } }
                  myctl[fq * 4] = (unsigned)(fr * 16 + bin); myctl[fq * 4 + 1] = want - cum; } }
            asm volatile("s_waitcnt lgkmcnt(0)" ::: "memory");
            const unsigned b0 = myctl[fq * 4];
            idx_sweep<2, false>(KIb, nch, stage, tid, tq, fr, fq, aq, wv, wp, myhist, b0, myctl, mycand, out);
            { const unsigned nc = myctl[fq * 4 + 3], need = myctl[fq * 4 + 1]; const int n = (int)(nc < 128u ? nc : 128u);
              for (int ci = fr; ci < n; ci += 16) { const unsigned ki = mycand[(fq * 128 + ci) * 2], ii = mycand[(fq * 128 + ci) * 2 + 1]; unsigned rk = 0u;
                  for (int jx = 0; jx < n; ++jx) { const unsigned kj = mycand[(fq * 128 + jx) * 2], ij = mycand[(fq * 128 + jx) * 2 + 1]; rk += (kj > ki || (kj == ki && ij < ii)) ? 1u : 0u; }
                  if (rk < need) { const unsigned pos = atomicAdd(&myctl[fq * 4 + 2], 1u); ((unsigned short*)myhist)[fq * 256 + (pos & 255u)] = (unsigned short)ii; } } }
            asm volatile("s_waitcnt lgkmcnt(0)" ::: "memory");
            { const uint4* sp = (const uint4*)((const unsigned short*)myhist + fq * 256 + fr * 16); uint4* dp = (uint4*)(out + fr * 16); dp[0] = sp[0]; dp[1] = sp[1]; }
            if (fr == 0) CNT[tokbase + tq] = (int)myctl[fq * 4 + 2];
            __syncthreads();
        }
    }
}

__device__ __forceinline__ void dsa_attend(const h16* PROJ, const unsigned short* IDX, const int* CNT, h16* MIXA, unsigned char* shm, unsigned* bar, unsigned xcc, unsigned xrank) {
    float* Pl = (float*)shm;
    unsigned short* selw = (unsigned short*)(shm + 32768);
    int tid_ = threadIdx.x; asm volatile("" : "+v"(tid_));
    const int tid = tid_, wid = tid >> 6, lane = tid & 63, fr = lane & 15, fq = lane >> 4;
    unsigned short* sel = selw + wid * 256;
    const int qq = 0;
    for (int u = 0; u < 2 * NBATCH; ++u) {
        int rank, total; if (!xcd_unit_rank(bar, xcc, xrank, 2 * NBATCH, u, rank, total)) continue;
        const int b = u >> 1, g = u & 1, tokbase = b * SEQ;
        for (int it = rank; it < 1024; it += total) {
            const int t = it * 8 + wid, tokq = tokbase + t; int nsel = __builtin_amdgcn_readfirstlane(CNT[tokq]); nsel = nsel < 1 ? 1 : (nsel > 256 ? 256 : nsel);
            *(unsigned long long*)(sel + 4 * lane) = *(const unsigned long long*)(IDX + (size_t)tokq * 256 + 4 * lane);
            asm volatile("s_waitcnt vmcnt(0) lgkmcnt(0)" ::: "memory");
            h16x8 qa[4];
#pragma unroll
            for (int kk = 0; kk < 4; ++kk) { h16x8 z;
#pragma unroll
                for (int e = 0; e < 8; ++e) z[e] = (h16)0.f;
                qa[kk] = z; }
            if (fr < 4) { const h16* qrow = PROJ + O_Q + (size_t)tokq * 1024 + (g * 4 + fr) * 128 + 16 * fq;
#pragma unroll
                for (int kk = 0; kk < 4; ++kk) qa[kk] = *(const h16x8*)(qrow + (kk & 1) * 8 + (kk >> 1) * 64); }
            long qa8[4];
#pragma unroll
            for (int kk = 0; kk < 4; ++kk) {
                int w0 = __builtin_amdgcn_cvt_pk_fp8_f32((float)qa[kk][0], (float)qa[kk][1], 0, false); w0 = __builtin_amdgcn_cvt_pk_fp8_f32((float)qa[kk][2], (float)qa[kk][3], w0, true);
                int w1 = __builtin_amdgcn_cvt_pk_fp8_f32((float)qa[kk][4], (float)qa[kk][5], 0, false); w1 = __builtin_amdgcn_cvt_pk_fp8_f32((float)qa[kk][6], (float)qa[kk][7], w1, true);
                qa8[kk] = (long)(((unsigned long long)(unsigned)w1 << 32) | (unsigned long long)(unsigned)w0); }
            f32x4 sacc[16];
            const unsigned char* kbase8 = (const unsigned char*)(PROJ + O_KG) + (size_t)(b * 2 + g) * SEQ * 128 + 16 * fq;
            {
                uint4 kf[16][2];
#pragma unroll
                for (int e = 0; e < 16; ++e) { const int slot = 16 * e + fr; const int idx = (int)sel[qq * 256 + (slot < nsel ? slot : nsel - 1)];
                    const unsigned char* krow = kbase8 + (size_t)idx * 128;
                    kf[e][0] = *(const uint4*)krow; kf[e][1] = *(const uint4*)(krow + 64); }
                __builtin_amdgcn_sched_barrier(0);
#pragma unroll
                for (int e = 0; e < 16; ++e) {
                    f32x4 a = (f32x4){0.f, 0.f, 0.f, 0.f};
#pragma unroll
                    for (int L = 0; L < 2; ++L) {
                        const long k0 = (long)(((unsigned long long)kf[e][L].y << 32) | (unsigned long long)kf[e][L].x), k1 = (long)(((unsigned long long)kf[e][L].w << 32) | (unsigned long long)kf[e][L].z);
                        a = __builtin_amdgcn_mfma_f32_16x16x32_fp8_fp8(qa8[2 * L], k0, a, 0, 0, 0); a = __builtin_amdgcn_mfma_f32_16x16x32_fp8_fp8(qa8[2 * L + 1], k1, a, 0, 0, 0); }
                    if (16 * e + fr >= nsel) a = (f32x4){-1e30f, -1e30f, -1e30f, -1e30f};
                    sacc[e] = a; }
                __builtin_amdgcn_sched_barrier(0);
            }
            f32x4 mx = sacc[0];
#pragma unroll
            for (int jt = 1; jt < 16; ++jt)
#pragma unroll
                for (int i = 0; i < 4; ++i) mx[i] = fmaxf(mx[i], sacc[jt][i]);
#pragma unroll
            for (int o = 1; o < 16; o <<= 1)
#pragma unroll
                for (int i = 0; i < 4; ++i) mx[i] = fmaxf(mx[i], __shfl_xor(mx[i], o));
            f32x4 sm = (f32x4){0.f, 0.f, 0.f, 0.f};
            const float sc = 0.08838834764831845f;
#pragma unroll
            for (int jt = 0; jt < 16; ++jt)
#pragma unroll
                for (int i = 0; i < 4; ++i) { const float e = __expf((sacc[jt][i] - mx[i]) * sc); sacc[jt][i] = e; sm[i] += e; }
#pragma unroll
            for (int o = 1; o < 16; o <<= 1)
#pragma unroll
                for (int i = 0; i < 4; ++i) sm[i] += __shfl_xor(sm[i], o);
            f32x4 inv;
#pragma unroll
            for (int i = 0; i < 4; ++i) inv[i] = 1.f / sm[i];
            if (fq == 0) {
#pragma unroll
                for (int jt = 0; jt < 16; ++jt) *(f32x4*)(Pl + ((size_t)wid * 256 + 16 * jt + fr) * 4) = sacc[jt] * inv;
            }
            asm volatile("s_waitcnt lgkmcnt(0)" ::: "memory");
            const int r8 = lane >> 3, c8 = lane & 7;
            const unsigned char* vbase8 = (const unsigned char*)(PROJ + O_VG) + (size_t)(b * 2 + g) * SEQ * 128 + 16 * c8;
            f32x2 oa2[4][8];
#pragma unroll
            for (int h = 0; h < 4; ++h)
#pragma unroll
                for (int d = 0; d < 8; ++d) oa2[h][d] = (f32x2){0.f, 0.f};
            for (int s0 = 0; s0 < nsel; s0 += 128) {
                uint4 vv[16];
#pragma unroll
                for (int e = 0; e < 16; ++e) { const int slot = s0 + 8 * e + r8; const int idx = (int)sel[qq * 256 + (slot < nsel ? slot : nsel - 1)];
                    vv[e] = *(const uint4*)(vbase8 + (size_t)idx * 128); }
                __builtin_amdgcn_sched_barrier(0);
#pragma unroll
                for (int e = 0; e < 16; ++e) { const int slot = s0 + 8 * e + r8;
                    if ((e & 3) == 0) __builtin_amdgcn_sched_barrier(0);
                    const f32x4 pp = *(const f32x4*)(Pl + ((size_t)wid * 256 + slot) * 4);
                    const f32x2 p0 = (f32x2){pp.x, pp.x}, p1 = (f32x2){pp.y, pp.y}, p2 = (f32x2){pp.z, pp.z}, p3 = (f32x2){pp.w, pp.w};
                    const unsigned wds[4] = {vv[e].x, vv[e].y, vv[e].z, vv[e].w};
#pragma unroll
                    for (int w = 0; w < 4; ++w) {
                        const f32x2 lo = __builtin_amdgcn_cvt_pk_f32_fp8((int)wds[w], false), hi = __builtin_amdgcn_cvt_pk_f32_fp8((int)wds[w], true);
                        oa2[0][2 * w] = __builtin_elementwise_fma(lo, p0, oa2[0][2 * w]); oa2[0][2 * w + 1] = __builtin_elementwise_fma(hi, p0, oa2[0][2 * w + 1]);
                        oa2[1][2 * w] = __builtin_elementwise_fma(lo, p1, oa2[1][2 * w]); oa2[1][2 * w + 1] = __builtin_elementwise_fma(hi, p1, oa2[1][2 * w + 1]);
                        oa2[2][2 * w] = __builtin_elementwise_fma(lo, p2, oa2[2][2 * w]); oa2[2][2 * w + 1] = __builtin_elementwise_fma(hi, p2, oa2[2][2 * w + 1]);
                        oa2[3][2 * w] = __builtin_elementwise_fma(lo, p3, oa2[3][2 * w]); oa2[3][2 * w + 1] = __builtin_elementwise_fma(hi, p3, oa2[3][2 * w + 1]); }
                }
            }
#pragma unroll
            for (int h = 0; h < 4; ++h)
#pragma unroll
                for (int d = 0; d < 8; ++d) { f32x2 v = oa2[h][d];
                    v.x += __shfl_xor(v.x, 8); v.y += __shfl_xor(v.y, 8); v.x += __shfl_xor(v.x, 16); v.y += __shfl_xor(v.y, 16); v.x += __shfl_xor(v.x, 32); v.y += __shfl_xor(v.y, 32); oa2[h][d] = v; }
            if (r8 == 0) {
                h16* orow = MIXA + (size_t)tokq * DM + (g * 4) * 128 + 16 * c8;
#pragma unroll
                for (int h = 0; h < 4; ++h) { h16x8 w0, w1;
#pragma unroll
                    for (int d = 0; d < 4; ++d) { w0[2 * d] = (h16)oa2[h][d].x; w0[2 * d + 1] = (h16)oa2[h][d].y; w1[2 * d] = (h16)oa2[h][4 + d].x; w1[2 * d + 1] = (h16)oa2[h][4 + d].y; }
                    *(h16x8*)(orow + h * 128) = w0; *(h16x8*)(orow + h * 128 + 8) = w1; }
            }
            asm volatile("s_waitcnt lgkmcnt(0)" ::: "memory");
        }
    }
}

__device__ __forceinline__ Gemm mk_gemm(const h16* A, int lda, const h16* Bt, int ldb, int M, int N, int K, int nB = 1, size_t sA = 0, size_t sB = 0) {
    Gemm g; g.A = A; g.Bt = Bt; g.lda = lda; g.ldb = ldb; g.nM = M / 256; g.nN = N / 256; g.nB = nB; g.K = K; g.strideA = sA; g.strideB = sB; return g;
}

__device__ __forceinline__ int opaque(int v) { asm volatile("" : "+v"(v)); return v; }
enum { K_FUP0 = 0, K_FDN0, K_LN0, K_MIE, K_S5A, K_CARRY, K_S5B, K_GLU, K_MO, K_LN1, K_FUP1, K_FDN1, K_LN2, K_PLE, K_MIO, K_DSA };
constexpr unsigned long long tbl_even() { const int k[13] = {K_FUP0, K_FDN0, K_LN0, K_MIE, K_S5A, K_S5B, K_GLU, K_MO, K_LN1, K_FUP1, K_FDN1, K_LN2, K_PLE}; unsigned long long r = 0; for (int i = 0; i < 13; ++i) r |= (unsigned long long)k[i] << (4 * i); return r; }
constexpr unsigned long long tbl_odd() { const int k[12] = {K_FUP0, K_FDN0, K_LN0, K_MIO, K_DSA, K_CARRY  , K_MO, K_LN1, K_FUP1, K_FDN1, K_LN2, K_PLE}; unsigned long long r = 0; for (int i = 0; i < 12; ++i) r |= (unsigned long long)k[i] << (4 * i); return r; }

__global__ void __launch_bounds__(512, 2) fwd_megakernel(Params P) {
    extern __shared__ __attribute__((aligned(16))) unsigned char shm[];
    cg::grid_group grid = cg::this_grid();
    LAS unsigned char* lds = (LAS unsigned char*)shm;
    volatile LAS unsigned* xbst = (volatile LAS unsigned*)(lds + LDS_BYTES - 16);
    if (threadIdx.x == 0) { const unsigned x_ = xb_xcc_id(); xbst[0] = 0u; xbst[1] = 0u; xbst[2] = xb_add(&((unsigned*)(P.ws + OFF_BAR))[XB_XCNT(x_)], 1u); xbst[3] = x_; }
    __syncthreads();

    if (blockIdx.x < 64) s5_build(P, blockIdx.x >> 5, blockIdx.x & 31, (float*)shm);
    prep_transposes(P, (float*)shm);
    cvt_pass(P.x, (h16*)(P.ws + OFF_MIXA), (size_t)NTOK * DM, nullptr);
    grid.sync();

    for (int i = 0; i < DEPTH; ++i) {
        const bool even = (i & 1) == 0; const int nst = even ? 13 : 12; const unsigned long long tbl = even ? tbl_even() : tbl_odd();
        for (int st = 0; st < nst; ++st) {
            const int kind = (int)((tbl >> (4 * st)) & 15ull), j = i >> 1;
            unsigned long long ka_ = (unsigned long long)__builtin_amdgcn_kernarg_segment_ptr(); asm volatile("" : "+s"(ka_));
            const __attribute__((address_space(4))) Params* PK = (const __attribute__((address_space(4))) Params*)ka_;
            unsigned char* ws = PK->ws;
            float* H = PK->out;
            h16* H16 = (h16*)(ws + OFF_H16);
            h16* MIXA = (h16*)(ws + OFF_MIXA);
            h16* R1 = (h16*)(ws + OFF_R1);
            h16* UG = (h16*)(ws + OFF_R1 + R1_UG);
            float* SLOC = (float*)(ws + OFF_R1 + R1_SLOC);
            h16* Z = (h16*)(ws + OFF_R1 + R1_Z);
            h16* P16 = (h16*)(ws + OFF_P16);
            EpiArgs E{};
            switch (kind) {
            case K_FUP0: case K_FUP1: {
                const int li = i * 2 + (kind == K_FUP1 ? 1 : 0);
                E.h0 = R1;
                gemm_phase<E_SWIGLU>(lds, mk_gemm(kind == K_FUP0 ? MIXA : H16, DM, (const h16*)(ws + OFF_W13 + li * SZ_W13), DM, NTOK, 5632, DM), E);
            } break;
            case K_FDN0: case K_FDN1: case K_MO: {
                E.ch0 = (kind == K_FDN0) ? MIXA : H16; E.h0 = H16;
                if (kind == K_MO) { E.s0 = 1.f;
                    gemm_phase<E_RES>(lds, mk_gemm(MIXA, DM, (const h16*)(ws + (even ? OFF_ABOUT : OFF_COUT) + j * SZ_SQ), DM, NTOK, DM, DM), E);
                } else { const int li = i * 2 + (kind == K_FDN1 ? 1 : 0); E.s0 = 0.5f;
                    gemm_phase<E_RES>(lds, mk_gemm(R1, DFF, (const h16*)(ws + OFF_W2T + li * SZ_W2T), DFF, NTOK, DM, DFF), E); }
            } break;
            case K_LN0: case K_LN1: case K_LN2: {
                const int idx = i * 3 + (kind == K_LN0 ? 0 : (kind == K_LN1 ? 1 : 2));
                ln_pass(H16, PK->ln_g + (size_t)idx * DM, PK->ln_b + (size_t)idx * DM);
                if (kind == K_LN1) cvt_pass(PK->p + (size_t)i * NTOK * 256, P16, (size_t)NTOK * 256, nullptr);
                if (kind == K_LN2) { E.h0 = R1;
                    gemm_phase<E_PP>(lds, mk_gemm(P16, 256, (const h16*)(ws + OFF_WPT + i * SZ_WPT), 256, NTOK, DM, 256), E); }
            } break;
            case K_MIE: {
                E.h0 = R1; E.h1 = UG;
                gemm_phase<E_PROJ_EVEN>(lds, mk_gemm(H16, DM, (const h16*)(ws + OFF_ABIN + j * SZ_ABIN), DM, NTOK, 2048, DM), E);
            } break;
            case K_S5A: {
                E.f0 = SLOC;
                gemm_phase<E_S5A>(lds, mk_gemm(UG, 640, (const h16*)(ws + OFF_W1M + j * SZ_W1M), 512, 1024, 256, 512, 32, (size_t)1024 * 640, (size_t)256 * 512), E);
                for (int L = blockIdx.x; L < NBATCH * 32; L += gridDim.x) { __syncthreads(); carry_unit(SLOC, UG, (const float*)(ws + OFF_A32) + (size_t)j * 32 * 64 * 2, shm, L & 3, L >> 2); }
                conv_pass(R1, PK->convw + (size_t)j * 1536, MIXA);
            } break;
            case K_CARRY:
                dsa_attend(R1, (const unsigned short*)(ws + OFF_R1 + R1_IDX), (const int*)(ws + OFF_R1 + R1_CNT), MIXA, shm, (unsigned*)(ws + OFF_BAR), xbst[3], xbst[2]);
                break;
            case K_S5B: {
                E.ch0 = UG; E.cf0 = PK->s5d + (size_t)j * 512; E.h0 = Z;
                gemm_phase<E_S5B>(lds, mk_gemm(UG, 640, (const h16*)(ws + OFF_M2 + j * SZ_M2), 640, 1024, 512, 640, 32, (size_t)1024 * 640, (size_t)512 * 640), E);
            } break;
            case K_GLU: {
                E.ch0 = Z; E.cf0 = PK->bglu + (size_t)j * 512; E.h0 = MIXA;
                gemm_phase<E_GLU>(lds, mk_gemm(Z, 512, (const h16*)(ws + OFF_WGLU + j * SZ_WGLU), 512, NTOK, 512, 512), E);
            } break;
            case K_MIO: {
                E.h0 = R1; E.pos = PK->pos;
                gemm_phase<E_PROJ_ODD>(lds, mk_gemm(H16, DM, (const h16*)(ws + OFF_CIN + j * SZ_CIN), DM, NTOK, 2304, DM), E);
            } break;
            case K_DSA: dsa_select(R1, (unsigned short*)(ws + OFF_R1 + R1_IDX), (int*)(ws + OFF_R1 + R1_CNT), shm, (unsigned*)(ws + OFF_BAR), xbst[3], xbst[2]); break;
            case K_PLE: {
                E.f0 = (i == DEPTH - 1) ? H : nullptr; E.ch0 = R1; E.ch1 = H16; E.h0 = MIXA;
                gemm_phase<E_PLE>(lds, mk_gemm(H16, DM, (const h16*)(ws + OFF_WGT + i * SZ_SQ), DM, NTOK, DM, DM), E);
            } break;
            }
            xcd_barrier((unsigned*)(ws + OFF_BAR), xbst);
        }
    }
}

extern "C" void kernel_launch(void* const* d_in, const int* in_sizes, int n_in, void* d_out, int out_size, void* d_ws, size_t ws_size, hipStream_t stream) {
    static int grid_blocks = 0;
    if (grid_blocks == 0) {
        if (n_in != 25 || out_size != NTOK * DM || ws_size < WS_END) { fprintf(stderr, "kernel_launch: unexpected shapes (n_in %d, out %d, ws %zu, need %zu)\n", n_in, out_size, ws_size, (size_t)WS_END); grid_blocks = -1; return; }
        int dev = 0, cus = 0, per_cu = 0;
        hipGetDevice(&dev);
        hipDeviceGetAttribute(&cus, hipDeviceAttributeMultiprocessorCount, dev);
        if (hipFuncSetAttribute((const void*)fwd_megakernel, hipFuncAttributeMaxDynamicSharedMemorySize, LDS_BYTES) != hipSuccess) { fprintf(stderr, "kernel_launch: hipFuncSetAttribute failed\n"); grid_blocks = -1; return; }
        if (hipOccupancyMaxActiveBlocksPerMultiprocessor(&per_cu, (const void*)fwd_megakernel, 512, LDS_BYTES) != hipSuccess || per_cu < 1) { fprintf(stderr, "kernel_launch: occupancy query says %d\n", per_cu); per_cu = 1; }
        (void)hipGetLastError();
        grid_blocks = cus * per_cu;
    }
    if (grid_blocks < 0) return;
    Params p{};
    p.x = (const float*)d_in[0]; p.p = (const float*)d_in[1]; p.pos = (const int*)d_in[2];
    p.ln_g = (const float*)d_in[3]; p.ln_b = (const float*)d_in[4]; p.w1 = (const float*)d_in[5]; p.w3 = (const float*)d_in[6]; p.w2 = (const float*)d_in[7];
    p.plep = (const float*)d_in[8]; p.pleg = (const float*)d_in[9]; p.abin = (const float*)d_in[10]; p.about = (const float*)d_in[11]; p.convw = (const float*)d_in[12];
    p.lamre = (const float*)d_in[13]; p.lamim = (const float*)d_in[14]; p.logdt = (const float*)d_in[15]; p.bre = (const float*)d_in[16]; p.bim = (const float*)d_in[17];
    p.cre = (const float*)d_in[18]; p.cim = (const float*)d_in[19]; p.s5d = (const float*)d_in[20]; p.wglu = (const float*)d_in[21]; p.bglu = (const float*)d_in[22];
    p.cin = (const float*)d_in[23]; p.cout = (const float*)d_in[24];
    p.out = (float*)d_out; p.ws = (unsigned char*)d_ws;
    if (hipMemsetAsync((char*)d_ws + OFF_BAR, 0, 16384, stream) != hipSuccess) { fprintf(stderr, "kernel_launch: memset of barrier words failed\n"); return; }
    void* args[] = {&p};
    hipError_t e = hipLaunchCooperativeKernel((const void*)fwd_megakernel, dim3(grid_blocks), dim3(512), args, LDS_BYTES, stream);
    if (e != hipSuccess) fprintf(stderr, "cooperative launch failed: %s (grid %d)\n", hipGetErrorString(e), grid_blocks);
}
```

```cpp
#include <hip/hip_runtime.h>
#include <hip/hip_cooperative_groups.h>
#include <cstdio>
namespace cg = cooperative_groups;

#define LAS __attribute__((address_space(3)))
typedef _Float16 h16;
typedef _Float16 h16x8 __attribute__((ext_vector_type(8)));
typedef _Float16 h16x4 __attribute__((ext_vector_type(4)));
typedef _Float16 h16x2 __attribute__((ext_vector_type(2)));
typedef float f32x4 __attribute__((ext_vector_type(4)));
typedef float f32x2 __attribute__((ext_vector_type(2)));

constexpr int NTOK = 32768, DM = 1024, DFF = 2816, SEQ = 8192, NBATCH = 4, DEPTH = 4;
constexpr float DN_ALPHA = 1.6817928305074292f;
constexpr float LN_EPS = 1e-5f;
constexpr int LDS_BYTES = 147456;

constexpr size_t SZ_W13 = (size_t)5632 * 1024 * 2, SZ_W2T = (size_t)1024 * 2816 * 2, SZ_WPT = (size_t)1024 * 256 * 2, SZ_SQ = (size_t)1024 * 1024 * 2;
constexpr size_t SZ_ABIN = (size_t)2048 * 1024 * 2, SZ_WGLU = (size_t)512 * 512 * 2, SZ_CIN = (size_t)2304 * 1024 * 2;
constexpr size_t SZ_W1M = (size_t)32 * 256 * 512 * 2, SZ_M2 = (size_t)32 * 512 * 640 * 2;
constexpr size_t OFF_W13 = 0;
constexpr size_t OFF_W2T = OFF_W13 + 8 * SZ_W13;
constexpr size_t OFF_WPT = OFF_W2T + 8 * SZ_W2T;
constexpr size_t OFF_WGT = OFF_WPT + 4 * SZ_WPT;
constexpr size_t OFF_ABIN = OFF_WGT + 4 * SZ_SQ;
constexpr size_t OFF_ABOUT = OFF_ABIN + 2 * SZ_ABIN;
constexpr size_t OFF_WGLU = OFF_ABOUT + 2 * SZ_SQ;
constexpr size_t OFF_CIN = OFF_WGLU + 2 * SZ_WGLU;
constexpr size_t OFF_COUT = OFF_CIN + 2 * SZ_CIN;
constexpr size_t OFF_W1M = OFF_COUT + 2 * SZ_SQ;
constexpr size_t OFF_M2 = OFF_W1M + 2 * SZ_W1M;
constexpr size_t OFF_A32 = OFF_M2 + 2 * SZ_M2;
constexpr size_t OFF_H16 = OFF_A32 + 65536;
constexpr size_t OFF_R1 = OFF_H16 + (size_t)NTOK * DM * 2;
constexpr size_t SZ_R1 = (size_t)201326592;
constexpr size_t OFF_MIXA = OFF_R1 + SZ_R1;
constexpr size_t OFF_P16 = OFF_MIXA + (size_t)NTOK * DM * 2;
constexpr size_t OFF_BAR = OFF_P16 + (size_t)NTOK * 256 * 2;
constexpr size_t WS_END = OFF_BAR + 16384;
constexpr size_t R1_UG = (size_t)NTOK * 1536 * 2;
constexpr size_t R1_SLOC = R1_UG + (size_t)32 * 1024 * 640 * 2;
constexpr size_t R1_Z = R1_SLOC + (size_t)32 * 1024 * 128 * 4;
static_assert(R1_Z + (size_t)NTOK * 512 * 2 <= SZ_R1, "R1 layout");
constexpr size_t O_Q = 0, O_KG = (size_t)NTOK * 1024, O_VG = O_KG + (size_t)NTOK * 256, O_QI = O_VG + (size_t)NTOK * 256, O_KI = O_QI + (size_t)NTOK * 512, O_WI = O_KI + (size_t)NTOK * 64;
constexpr size_t R1_IDX = (O_WI + (size_t)NTOK * 8) * 2;
constexpr size_t R1_CNT = R1_IDX + (size_t)NTOK * 256 * 2;
static_assert(R1_CNT + (size_t)NTOK * 4 <= SZ_R1, "R1 layout (odd)");

struct Params {
    const float* x; const float* p; const int* pos;
    const float *ln_g, *ln_b, *w1, *w3, *w2, *plep, *pleg, *abin, *about, *convw, *lamre, *lamim, *logdt, *bre, *bim, *cre, *cim, *s5d, *wglu, *bglu, *cin, *cout;
    float* out; unsigned char* ws;
};

__device__ __forceinline__ float sigmoidf_(float x) { return __builtin_amdgcn_rcpf(1.f + __expf(-x)); }
__device__ __forceinline__ float gelu_tanh(float x) { const float u = 0.7978845608028654f * (x + 0.044715f * x * x * x); return 0.5f * x * (2.f - 2.f * __builtin_amdgcn_rcpf(1.f + __expf(2.f * u))); }
__device__ __forceinline__ h16x4 cvt4(f32x4 v) { h16x4 r; r.x = (h16)v.x; r.y = (h16)v.y; r.z = (h16)v.z; r.w = (h16)v.w; return r; }
__device__ __forceinline__ float wave_sum(float v) {
#pragma unroll
    for (int o = 1; o < 64; o <<= 1) v += __shfl_xor(v, o);
    return v;
}
__device__ __forceinline__ void rope_sc(float pos, float inv, float& c, float& s) {
    const float ang = pos * inv;
    const double a = (double)ang;
    const double n = __builtin_rint(a * 0.15915494309189535);
    const float r = (float)(a - n * 6.283185307179586);
    s = __sinf(r); c = __cosf(r);
}

constexpr int BM = 256, BK = 64, HALF = 128, HTB = HALF * BK * 2, NXCD = 8, WGM = 8;
__device__ __forceinline__ int lds_byte(int r, int c) { const int st = (r >> 4) * 2 + (c >> 5), rr = r & 15, cc = c & 31, ob = rr * 64 + cc * 2; return st * 1024 + (ob ^ (((ob >> 9) & 1) << 5)); }
__device__ __forceinline__ void stage_rc(int b, int& R, int& C) { const int st = b / 1024, sb = b % 1024, swz = sb ^ (((sb >> 9) & 1) << 5); R = (st >> 1) * 16 + swz / 64; C = (st & 1) * 32 + (swz % 64) / 2; }

struct Unit { int pb, pm, pn; };
struct Gemm { const h16* A; const h16* Bt; int lda, ldb, nM, nN, nB, K; size_t strideA, strideB; };
struct EpiArgs { float* f0; const float* cf0; h16* h0; h16* h1; const h16* ch0; const h16* ch1; const int* pos; float s0; };

__device__ __forceinline__ bool unit_next(const Gemm& g, int i, Unit& u) {
    const int nwg = g.nM * g.nN; const long L = (long)i * gridDim.x + blockIdx.x; if (L >= (long)nwg * g.nB) return false;
    u.pb = (int)(L / nwg); int wgid = (int)(L % nwg);
    { const int q = nwg / NXCD, r = nwg % NXCD, xcd = wgid % NXCD, off = wgid / NXCD; wgid = (xcd < r ? xcd * (q + 1) : r * (q + 1) + (xcd - r) * q) + off; }
    const int nig = WGM * g.nN, gid = wgid / nig, fm = gid * WGM, gsz = (g.nM - fm) < WGM ? (g.nM - fm) : WGM;
    u.pm = fm + ((wgid % nig) % gsz); u.pn = (wgid % nig) / gsz; return true;
}

enum { E_SWIGLU = 0, E_RES = 1, E_PROJ_EVEN = 2, E_S5A = 3, E_S5B = 4, E_GLU = 5, E_PROJ_ODD = 6, E_PP = 7, E_PLE = 8 };

template <int MODE>
__device__ __forceinline__ void epilogue(const f32x4 (&acc)[2][2][4][2], const Unit& u, const EpiArgs& E, int wr, int wc, int fr, int fq) {
    const int row0 = u.pm * BM + wr * 64 + fr, tc0 = wc * 32 + 4 * fq;
    h16* obase = nullptr; int orstride = 0, obstride = 0;
    if constexpr (MODE == E_PROJ_ODD) {
        if (u.pn < 4) { obase = E.h0 + O_Q + u.pn * 256; orstride = 1024; obstride = 128; }
        else if (u.pn < 6) { obase = E.h0 + (u.pn == 4 ? O_KG : O_VG) + (size_t)((u.pm * BM) >> 13) * SEQ * 128; orstride = 128; obstride = SEQ * 128; }
        else if (u.pn < 8) { obase = E.h0 + O_QI + (u.pn - 6) * 256; orstride = 512; obstride = 128; }
        else { obase = E.h0 + O_KI; orstride = 64; obstride = 0; }
    }
    int posv[8];
    if constexpr (MODE == E_PROJ_ODD) {
#pragma unroll
        for (int q = 0; q < 8; ++q) posv[q] = E.pos[row0 + (q >> 2) * HALF + (q & 3) * 16];
    }
#pragma unroll
    for (int ai = 0; ai < 2; ++ai) {
    h16x8 pre[4][2];
    if constexpr (MODE == E_RES || MODE == E_PLE || MODE == E_GLU) {
        const h16* pb = (MODE == E_PLE) ? E.ch1 : E.ch0; const int pld = (MODE == E_GLU) ? 512 : DM;
#pragma unroll
        for (int m = 0; m < 4; ++m)
#pragma unroll
            for (int bj = 0; bj < 2; ++bj) pre[m][bj] = *(const h16x8*)(pb + (size_t)(row0 + ai * HALF + m * 16) * pld + u.pn * 256 + bj * 128 + wc * 32 + 8 * fq);
    }
#pragma unroll
        for (int m = 0; m < 4; ++m) {
            int row = row0 + ai * HALF + m * 16; asm volatile("" : "+v"(row));
            if constexpr (MODE == E_SWIGLU) {
#pragma unroll
                for (int bj = 0; bj < 2; ++bj) {
                    const f32x4 a = acc[ai][bj][m][0], b = acc[ai][bj][m][1]; f32x4 o;
#pragma unroll
                    for (int j = 0; j < 4; ++j) o[j] = a[j] * sigmoidf_(a[j]) * b[j];
                    const int hc = u.pn * 128 + bj * 64 + wc * 16 + 4 * fq;
                    *(h16x4*)(E.h0 + (size_t)row * DFF + hc) = cvt4(o);
                }
            } else if constexpr (MODE == E_PROJ_ODD) {
                const float pos = (float)posv[ai * 4 + m];
                float cs[4], sn[4];
                const bool rot_a = (u.pn <= 4) && (wc == 0);
                const bool rot_i = (u.pn >= 6) && ((u.pn < 8) ? ((wc & 1) == 0) : (wc == 0));
                if (rot_a) {
#pragma unroll
                    for (int j = 0; j < 4; ++j) rope_sc(pos, exp2f(-(float)(4 * fq + j) * (18.931568569324174f / 16.f)), cs[j], sn[j]);
                } else if (rot_i) {
#pragma unroll
                    for (int j = 0; j < 4; ++j) rope_sc(pos, exp2f(-(float)((4 * fq + j) & 7) * (18.931568569324174f / 8.f)), cs[j], sn[j]);
                }
#pragma unroll
                for (int bj = 0; bj < 2; ++bj) {
                    f32x4 v0 = acc[ai][bj][m][0], v1 = acc[ai][bj][m][1];
                    if (rot_a) {
                        f32x4 t0, t1;
#pragma unroll
                        for (int j = 0; j < 4; ++j) { t0[j] = v0[j] * cs[j] - v1[j] * sn[j]; t1[j] = v1[j] * cs[j] + v0[j] * sn[j]; }
                        v0 = t0; v1 = t1;
                    }
                    if (u.pn >= 6) {
                        f32x4 y;
#pragma unroll
                        for (int j = 0; j < 4; ++j) y[j] = __shfl_xor(v0[j], 32);
                        if (rot_i && (u.pn < 8 || bj == 0)) {
#pragma unroll
                            for (int j = 0; j < 4; ++j) v0[j] = (fq < 2) ? (v0[j] * cs[j] - y[j] * sn[j]) : (v0[j] * cs[j] + y[j] * sn[j]);
                        }
                    }
                    if (u.pn == 4 || u.pn == 5) {
                        unsigned char* o8 = (unsigned char*)(E.h0 + (u.pn == 4 ? O_KG : O_VG)) + ((size_t)((row >> 13) * 2 + bj) * SEQ + (row & (SEQ - 1))) * 128 + tc0;
                        int w0 = __builtin_amdgcn_cvt_pk_fp8_f32(v0[0], v0[1], 0, false); w0 = __builtin_amdgcn_cvt_pk_fp8_f32(v0[2], v0[3], w0, true);
                        int w1 = __builtin_amdgcn_cvt_pk_fp8_f32(v1[0], v1[1], 0, false); w1 = __builtin_amdgcn_cvt_pk_fp8_f32(v1[2], v1[3], w1, true);
                        *(int*)o8 = w0; *(int*)(o8 + 16) = w1;
                    } else if (u.pn < 8 || (bj == 0 && wc < 2)) { h16* o = obase + (size_t)row * orstride + bj * obstride + tc0; *(h16x4*)o = cvt4(v0); *(h16x4*)(o + 16) = cvt4(v1); }
                    else if (bj == 0 && wc == 2 && fq < 2) *(h16x4*)(E.h0 + O_WI + (size_t)row * 8 + 4 * fq) = cvt4(v0);
                }
            } else if constexpr (MODE == E_RES || MODE == E_PLE || MODE == E_PP || MODE == E_GLU) {
#pragma unroll
                for (int bj = 0; bj < 2; ++bj) {
                    const int col = u.pn * 256 + bj * 128 + wc * 32 + 8 * fq;
                    const f32x4 v0 = acc[ai][bj][m][0], v1 = acc[ai][bj][m][1];
                    float vv[8] = {v0[0], v0[1], v0[2], v0[3], v1[0], v1[1], v1[2], v1[3]};
                    h16x8 o;
                    if constexpr (MODE == E_RES) {
                        const h16x8 hh = pre[m][bj];
#pragma unroll
                        for (int j = 0; j < 8; ++j) o[j] = (h16)((float)hh[j] * DN_ALPHA + vv[j] * E.s0);
                        *(h16x8*)(E.h0 + (size_t)row * DM + col) = o;
                    } else if constexpr (MODE == E_GLU) {
                        const h16x8 zz = pre[m][bj]; const f32x4 b0 = *(const f32x4*)(E.cf0 + col), b1 = *(const f32x4*)(E.cf0 + col + 4);
                        const float bb[8] = {b0[0], b0[1], b0[2], b0[3], b1[0], b1[1], b1[2], b1[3]};
#pragma unroll
                        for (int j = 0; j < 8; ++j) o[j] = (h16)((float)zz[j] * sigmoidf_(vv[j] + bb[j]));
                        *(h16x8*)(E.h0 + (size_t)row * DM + 512 + col) = o;
                    } else if constexpr (MODE == E_PP) {
#pragma unroll
                        for (int j = 0; j < 8; ++j) o[j] = (h16)vv[j];
                        *(h16x8*)(E.h0 + (size_t)row * DM + col) = o;
                    } else {
                        const h16x8 hh = pre[m][bj]; const h16x8 pp = *(const h16x8*)(E.ch0 + (size_t)row * DM + col); float of[8];
#pragma unroll
                        for (int j = 0; j < 8; ++j) { of[j] = (float)hh[j] + (float)pp[j] * sigmoidf_(vv[j]); o[j] = (h16)of[j]; }
                        if (E.f0) { *(f32x4*)(E.f0 + (size_t)row * DM + col) = (f32x4){of[0], of[1], of[2], of[3]}; *(f32x4*)(E.f0 + (size_t)row * DM + col + 4) = (f32x4){of[4], of[5], of[6], of[7]}; }
                        *(h16x8*)(E.h0 + (size_t)row * DM + col) = o;
                    }
                }
            } else {
#pragma unroll
                for (int bj = 0; bj < 2; ++bj)
#pragma unroll
                    for (int n = 0; n < 2; ++n) {
                        const int tc = bj * 128 + tc0 + n * 16, col = u.pn * 256 + tc;
                        const f32x4 v = acc[ai][bj][m][n];
                        if constexpr (MODE == E_RES) {
                            const h16x4 hh = *(const h16x4*)(E.ch0 + (size_t)row * DM + col); f32x4 y;
#pragma unroll
                            for (int j = 0; j < 4; ++j) y[j] = (float)hh[j] * DN_ALPHA + v[j] * E.s0;
                            *(h16x4*)(E.h0 + (size_t)row * DM + col) = cvt4(y);
                        } else if constexpr (MODE == E_PROJ_EVEN) {
                            if (u.pn < 6) *(h16x4*)(E.h0 + (size_t)row * 1536 + col) = cvt4(v);
                            else { const int ch = col - 1536, g = ch >> 4, ci = ch & 15;
                                *(h16x4*)(E.h1 + ((size_t)g * 1024 + (row >> 5)) * 640 + (row & 31) * 16 + ci) = cvt4(v); }
                        } else if constexpr (MODE == E_S5A) {
                            if (bj == 0) *(f32x4*)(E.f0 + ((size_t)u.pb * 1024 + row) * 128 + tc) = v * (1.f / 1024.f);
                        } else if constexpr (MODE == E_S5B) {
                            const int t = col >> 4, co = col & 15, ch = u.pb * 16 + co;
                            const h16x4 uu = *(const h16x4*)(E.ch0 + ((size_t)u.pb * 1024 + row) * 640 + col);
                            const f32x4 d = *(const f32x4*)(E.cf0 + ch); f32x4 z;
#pragma unroll
                            for (int j = 0; j < 4; ++j) z[j] = gelu_tanh(v[j] * (1.f / 1024.f) + d[j] * (float)uu[j]);
                            *(h16x4*)(E.h0 + ((size_t)row * 32 + t) * 512 + ch) = cvt4(z);
                        } else if constexpr (MODE == E_GLU) {
                            const h16x4 zz = *(const h16x4*)(E.ch0 + (size_t)row * 512 + col); const f32x4 bb = *(const f32x4*)(E.cf0 + col); f32x4 o;
#pragma unroll
                            for (int j = 0; j < 4; ++j) o[j] = (float)zz[j] * sigmoidf_(v[j] + bb[j]);
                            *(h16x4*)(E.h0 + (size_t)row * DM + 512 + col) = cvt4(o);
                        } else if constexpr (MODE == E_PP) {
                            *(h16x4*)(E.h0 + (size_t)row * DM + col) = cvt4(v);
                        } else if constexpr (MODE == E_PLE) {
                            const h16x4 hh = *(const h16x4*)(E.ch1 + (size_t)row * DM + col); const h16x4 pp = *(const h16x4*)(E.ch0 + (size_t)row * DM + col); f32x4 o;
#pragma unroll
                            for (int j = 0; j < 4; ++j) o[j] = (float)hh[j] + (float)pp[j] * sigmoidf_(v[j]);
                            if (E.f0) *(f32x4*)(E.f0 + (size_t)row * DM + col) = o;
                            *(h16x4*)(E.h0 + (size_t)row * DM + col) = cvt4(o);
                        }
                    }
            }
            __builtin_amdgcn_sched_barrier(0);
        }
    }
}

template <int MODE>
__device__ __forceinline__ void gemm_phase(LAS unsigned char* lds, const Gemm g, const EpiArgs E) {
    int tid_ = threadIdx.x; asm volatile("" : "+v"(tid_));
    const int tid = tid_, wid = __builtin_amdgcn_readfirstlane(tid >> 6), lane = tid & 63, wr = wid >> 2, wc = wid & 3, fr = lane & 15, fq = lane >> 4;
    const int K = g.K, nt = K / BK;
    unsigned voffA[2], voffB[2];
    constexpr bool PERM = (MODE == E_RES || MODE == E_PLE || MODE == E_PP || MODE == E_GLU);
#pragma unroll
    for (int i = 0; i < 2; ++i) { int R, C; stage_rc(tid * 16 + i * 8192, R, C);
        int Rb = R; if (PERM) { const int rho = R & 31, nn = rho >> 4, ii = rho & 15; Rb = (R & ~31) + 8 * (ii >> 2) + 4 * nn + (ii & 3); }
        voffA[i] = (unsigned)(R * g.lda + C) * 2u; voffB[i] = (unsigned)(Rb * g.ldb + C) * 2u; }
    const size_t kstep = (size_t)(BK * 2);
    const size_t hstepA = (size_t)HALF * g.lda * 2, hstepB = (size_t)HALF * g.ldb * 2;
    const unsigned ldsw = (unsigned)wid * 1024u;
    const int aoff = lds_byte(wr * 64 + fr, fq * 8), boff = lds_byte(wc * 32 + fr, fq * 8);
#define G_SA(b, h) (((b) * 2 + (h)) * HTB)
#define G_SB(b, h) ((4 + (b) * 2 + (h)) * HTB)
#define G_STAGE(bufoff, gbase, voff) do { _Pragma("unroll") for (int _i = 0; _i < 2; ++_i) \
        __builtin_amdgcn_global_load_lds((const unsigned*)((const char*)(gbase) + (voff)[_i]), (LAS unsigned*)(lds + (bufoff) + ldsw + _i * 8192), 16, 0, 0); } while (0)
#define G_LDA(dst, b, h) do { _Pragma("unroll") for (int m = 0; m < 4; ++m) _Pragma("unroll") for (int k = 0; k < 2; ++k) dst[m][k] = *(const LAS h16x8*)(lds + G_SA(b, h) + aoff + m * 2048 + k * 1024); } while (0)
#define G_LDB(dst, b, h) do { _Pragma("unroll") for (int n = 0; n < 2; ++n) _Pragma("unroll") for (int k = 0; k < 2; ++k) dst[n][k] = *(const LAS h16x8*)(lds + G_SB(b, h) + boff + n * 2048 + k * 1024); } while (0)
#define G_MMA(ai, bj, At, Bt) do { __builtin_amdgcn_s_setprio(1); _Pragma("unroll") for (int m = 0; m < 4; ++m) _Pragma("unroll") for (int n = 0; n < 2; ++n) _Pragma("unroll") for (int k = 0; k < 2; ++k) \
        acc[ai][bj][m][n] = __builtin_amdgcn_mfma_f32_16x16x32_f16(Bt[n][k], At[m][k], acc[ai][bj][m][n], 0, 0, 0); __builtin_amdgcn_s_setprio(0); } while (0)
#define G_WAIT_V(n) asm volatile("s_waitcnt vmcnt(" #n ")" ::: "memory")
#define G_WAIT_L(n) asm volatile("s_waitcnt lgkmcnt(" #n ")" ::: "memory")
#define G_BAR __builtin_amdgcn_s_barrier()
#define G_SCHED __builtin_amdgcn_sched_barrier(0)
    Unit cur, nxt; int ui = 0;
    if (!unit_next(g, 0, cur)) return;
    f32x4 acc[2][2][4][2];
#pragma unroll
    for (int a = 0; a < 2; ++a)
#pragma unroll
        for (int b = 0; b < 2; ++b)
#pragma unroll
            for (int m = 0; m < 4; ++m)
#pragma unroll
                for (int n = 0; n < 2; ++n) acc[a][b][m][n] = (f32x4){0.f, 0.f, 0.f, 0.f};
    h16x8 At[4][2], B0[2][2], B1[2][2];
    const char* cA = (const char*)(g.A + (size_t)cur.pb * g.strideA) + (size_t)cur.pm * 2 * hstepA;
    const char* cB = (const char*)(g.Bt + (size_t)cur.pb * g.strideB) + (size_t)cur.pn * 2 * hstepB;
    G_STAGE(G_SB(0, 0), cB, voffB); G_STAGE(G_SA(0, 0), cA, voffA); G_STAGE(G_SB(0, 1), cB + hstepB, voffB); G_STAGE(G_SA(0, 1), cA + hstepA, voffA);
    if (wr == 1) G_BAR;
    G_WAIT_V(4); G_BAR;
    G_STAGE(G_SB(1, 0), cB + kstep, voffB); G_STAGE(G_SA(1, 0), cA + kstep, voffA); G_STAGE(G_SB(1, 1), cB + hstepB + kstep, voffB);
    G_WAIT_V(6); G_BAR;
    for (;;) {
        const bool has_next = unit_next(g, ui + 1, nxt);
        const char* nA = has_next ? (const char*)(g.A + (size_t)nxt.pb * g.strideA) + (size_t)nxt.pm * 2 * hstepA : cA;
        const char* nB = has_next ? (const char*)(g.Bt + (size_t)nxt.pb * g.strideB) + (size_t)nxt.pn * 2 * hstepB : cB;
        for (int t = 0; t < nt; t += 2) {
            const bool last = (t == nt - 2);
            const char* a1 = cA + (size_t)(t + 1) * kstep;
            const char* a2 = last ? nA : cA + (size_t)(t + 2) * kstep; const char* b2 = last ? nB : cB + (size_t)(t + 2) * kstep;
            const char* a3 = a2 + kstep; const char* b3 = b2 + kstep;
            G_LDB(B0, 0, 0); G_SCHED; G_LDA(At, 0, 0); G_STAGE(G_SA(1, 1), a1 + hstepA, voffA);
            G_WAIT_L(8); G_BAR; G_WAIT_L(0); G_MMA(0, 0, At, B0); G_BAR; G_SCHED;
            G_LDB(B1, 0, 1); G_STAGE(G_SB(0, 0), b2, voffB);
            G_BAR; G_WAIT_L(0); G_MMA(0, 1, At, B1); G_BAR;
            G_LDA(At, 0, 1); G_STAGE(G_SA(0, 0), a2, voffA);
            G_BAR; G_WAIT_L(0); G_MMA(1, 0, At, B0); G_BAR; G_SCHED;
            G_STAGE(G_SB(0, 1), b2 + hstepB, voffB);
            G_WAIT_V(6); G_BAR; G_MMA(1, 1, At, B1); G_BAR;
            G_LDB(B0, 1, 0); G_SCHED; G_LDA(At, 1, 0); G_STAGE(G_SA(0, 1), a2 + hstepA, voffA);
            G_WAIT_L(8); G_BAR; G_WAIT_L(0); G_MMA(0, 0, At, B0); G_BAR; G_SCHED;
            G_LDB(B1, 1, 1); G_STAGE(G_SB(1, 0), b3, voffB);
            G_BAR; G_WAIT_L(0); G_MMA(0, 1, At, B1); G_BAR;
            G_LDA(At, 1, 1); G_STAGE(G_SA(1, 0), a3, voffA);
            G_BAR; G_WAIT_L(0); G_MMA(1, 0, At, B0); G_BAR; G_SCHED;
            G_STAGE(G_SB(1, 1), b3 + hstepB, voffB);
            G_WAIT_V(6); G_BAR; G_MMA(1, 1, At, B1); G_BAR;
        }
        epilogue<MODE>(acc, cur, E, wr, wc, fr, fq);
        if (!has_next) break;
#pragma unroll
        for (int a = 0; a < 2; ++a)
#pragma unroll
            for (int b = 0; b < 2; ++b)
#pragma unroll
                for (int m = 0; m < 4; ++m)
#pragma unroll
                    for (int n = 0; n < 2; ++n) acc[a][b][m][n] = (f32x4){0.f, 0.f, 0.f, 0.f};
        cur = nxt; cA = nA; cB = nB; ++ui;
    }
    G_WAIT_V(0);
    if (wr == 0) G_BAR;
    G_BAR;
#undef G_SA
#undef G_SB
#undef G_STAGE
#undef G_LDA
#undef G_LDB
#undef G_MMA
#undef G_WAIT_V
#undef G_WAIT_L
#undef G_BAR
#undef G_SCHED
}

__device__ __forceinline__ void tr_tile(const float* src, int N, int ldsrc, h16* dst, int lddst, int mode, int kb, int nb, float* scr) {
    const int t = threadIdx.x, k0 = kb * 64, n0 = nb * 64;
    { const int nl = t & 63, kl0 = t >> 6;
#pragma unroll
      for (int i = 0; i < 8; ++i) { const int kl = kl0 + 8 * i; scr[kl * 65 + nl] = (n0 + nl < N) ? src[(size_t)(k0 + kl) * ldsrc + n0 + nl] : 0.f; } }
    __syncthreads();
    { const int kp = t & 31, nl0 = t >> 5;
#pragma unroll
      for (int i = 0; i < 4; ++i) { const int nl = nl0 + 16 * i, n = n0 + nl;
          const int row = mode == 0 ? n : ((n >> 4) * 32 + (mode == 2 ? 16 : 0) + (n & 15));
          h16x2 v; v.x = (h16)scr[(2 * kp) * 65 + nl]; v.y = (h16)scr[(2 * kp + 1) * 65 + nl];
          *(h16x2*)(dst + (size_t)row * lddst + k0 + 2 * kp) = v; } }
    __syncthreads();
}

__device__ __forceinline__ void prep_transposes(const Params& P, float* scr) {
    unsigned char* ws = P.ws;
    constexpr int T_FFN = 704, N_FFN = 24 * T_FFN, T_PP = 64, T_SQ = 256, T_ABIN = 512, T_GLU = 64, T_CIN = 576;
    constexpr int TOTAL = N_FFN + 4 * T_PP + 4 * T_SQ + 2 * T_ABIN + 2 * T_SQ + 2 * T_GLU + 2 * T_CIN + 2 * T_SQ;
    constexpr int T1 = 12160;
    const int nb2 = (int)gridDim.x > 64 ? (int)gridDim.x - 64 : (int)gridDim.x;
    for (int it0 = blockIdx.x; ; ) {
        int it;
        if (it0 < T1) { it = it0; it0 += gridDim.x; if (it0 >= T1) it0 = (blockIdx.x >= 64 || gridDim.x <= 64) ? T1 + ((int)blockIdx.x >= 64 ? (int)blockIdx.x - 64 : (int)blockIdx.x) : TOTAL; }
        else { it = it0; it0 += nb2; }
        if (it >= TOTAL) break;
        int r = it;
        if (r < N_FFN) { const int mtx = r / T_FFN, tl = r % T_FFN, which = mtx / 8, li = mtx % 8;
            if (which == 0) tr_tile(P.w1 + (size_t)li * 1024 * 2816, 2816, 2816, (h16*)(ws + OFF_W13 + li * SZ_W13), 1024, 1, tl / 44, tl % 44, scr);
            else if (which == 1) tr_tile(P.w3 + (size_t)li * 1024 * 2816, 2816, 2816, (h16*)(ws + OFF_W13 + li * SZ_W13), 1024, 2, tl / 44, tl % 44, scr);
            else tr_tile(P.w2 + (size_t)li * 2816 * 1024, 1024, 1024, (h16*)(ws + OFF_W2T + li * SZ_W2T), 2816, 0, tl / 16, tl % 16, scr);
            continue; } r -= N_FFN;
        if (r < 4 * T_PP) { const int i = r / T_PP, tl = r % T_PP; tr_tile(P.plep + (size_t)i * 256 * 1024, 1024, 1024, (h16*)(ws + OFF_WPT + i * SZ_WPT), 256, 0, tl / 16, tl % 16, scr); continue; } r -= 4 * T_PP;
        if (r < 4 * T_SQ) { const int i = r / T_SQ, tl = r % T_SQ; tr_tile(P.pleg + (size_t)i * 1024 * 1024, 1024, 1024, (h16*)(ws + OFF_WGT + i * SZ_SQ), 1024, 0, tl / 16, tl % 16, scr); continue; } r -= 4 * T_SQ;
        if (r < 2 * T_ABIN) { const int i = r / T_ABIN, tl = r % T_ABIN; tr_tile(P.abin + (size_t)i * 1024 * 2048, 2048, 2048, (h16*)(ws + OFF_ABIN + i * SZ_ABIN), 1024, 0, tl / 32, tl % 32, scr); continue; } r -= 2 * T_ABIN;
        if (r < 2 * T_SQ) { const int i = r / T_SQ, tl = r % T_SQ; tr_tile(P.about + (size_t)i * 1024 * 1024, 1024, 1024, (h16*)(ws + OFF_ABOUT + i * SZ_SQ), 1024, 0, tl / 16, tl % 16, scr); continue; } r -= 2 * T_SQ;
        if (r < 2 * T_GLU) { const int i = r / T_GLU, tl = r % T_GLU; tr_tile(P.wglu + (size_t)i * 512 * 512, 512, 512, (h16*)(ws + OFF_WGLU + i * SZ_WGLU), 512, 0, tl / 8, tl % 8, scr); continue; } r -= 2 * T_GLU;
        if (r < 2 * T_CIN) { const int i = r / T_CIN, tl = r % T_CIN; tr_tile(P.cin + (size_t)i * 1024 * 2120, 2120, 2120, (h16*)(ws + OFF_CIN + i * SZ_CIN), 1024, 0, tl / 36, tl % 36, scr); continue; } r -= 2 * T_CIN;
        { const int i = r / T_SQ, tl = r % T_SQ; tr_tile(P.cout + (size_t)i * 1024 * 1024, 1024, 1024, (h16*)(ws + OFF_COUT + i * SZ_SQ), 1024, 0, tl / 16, tl % 16, scr); }
    }
}

__device__ __forceinline__ void s5_build(const Params& P, int j, int g, float* L) {
    float* abr = L;
    float* abi = L + 2112;
    float* bbr = L + 4224;
    float* bbi = L + 5248;
    float* ccr = L + 6272;
    float* cci = L + 7296;
    float* fre = L + 8320;
    float* fim = L + 8384;
    float* Kt = L + 8448;
    const int tid = threadIdx.x, jg = j * 32 + g;
    if (tid < 64) {
        const int p = tid;
        const float lr = fminf(P.lamre[jg * 64 + p], -1e-4f), li = P.lamim[jg * 64 + p], dt = expf(P.logdt[jg]);
        const float mag = expf(lr * dt), are = mag * cosf(li * dt), aim = mag * sinf(li * dt);
        const float nr = are - 1.f, ni = aim, den = lr * lr + li * li;
        fre[p] = (nr * lr + ni * li) / den; fim[p] = (ni * lr - nr * li) / den;
        float pr = 1.f, pi = 0.f;
        for (int d = 0; d <= 32; ++d) { abr[d * 64 + p] = pr; abi[d * 64 + p] = pi; const float t = pr * are - pi * aim; pi = pr * aim + pi * are; pr = t; }
    }
    __syncthreads();
    for (int e = tid; e < 1024; e += 512) {
        const int p = e >> 4;
        const float br = P.bre[(size_t)jg * 1024 + e], bi = P.bim[(size_t)jg * 1024 + e];
        bbr[e] = fre[p] * br - fim[p] * bi; bbi[e] = fre[p] * bi + fim[p] * br;
        ccr[e] = P.cre[(size_t)jg * 1024 + e]; cci[e] = P.cim[(size_t)jg * 1024 + e];
    }
    __syncthreads();
    for (int e = tid; e < 8192; e += 512) {
        const int d = e >> 8, co = (e >> 4) & 15, ci = e & 15; float s = 0.f;
        for (int p = 0; p < 64; ++p) {
            const float ar = abr[d * 64 + p], ai = abi[d * 64 + p], br = bbr[p * 16 + ci], bi = bbi[p * 16 + ci];
            const float wr_ = ar * br - ai * bi, wi_ = ar * bi + ai * br;
            s += ccr[co * 64 + p] * wr_ - cci[co * 64 + p] * wi_;
        }
        Kt[e] = s * 1024.f;
    }
    __syncthreads();
    h16* W1 = (h16*)(P.ws + OFF_W1M + (size_t)j * SZ_W1M) + (size_t)g * 256 * 512;
    for (int e = tid; e < 128 * 256; e += 512) {
        const int n = e >> 8, k = (e & 255) * 2, tau = k >> 4, ci = k & 15, p = n & 63, d = 31 - tau;
        const float ar = abr[d * 64 + p], ai = abi[d * 64 + p]; h16x2 v;
        if (n < 64) { v.x = (h16)(1024.f * (ar * bbr[p * 16 + ci] - ai * bbi[p * 16 + ci])); v.y = (h16)(1024.f * (ar * bbr[p * 16 + ci + 1] - ai * bbi[p * 16 + ci + 1])); }
        else { v.x = (h16)(1024.f * (ar * bbi[p * 16 + ci] + ai * bbr[p * 16 + ci])); v.y = (h16)(1024.f * (ar * bbi[p * 16 + ci + 1] + ai * bbr[p * 16 + ci + 1])); }
        *(h16x2*)(W1 + (size_t)n * 512 + k) = v;
        h16x2 z; z.x = (h16)0.f; z.y = (h16)0.f; *(h16x2*)(W1 + (size_t)(128 + n) * 512 + k) = z;
    }
    h16* M2 = (h16*)(P.ws + OFF_M2 + (size_t)j * SZ_M2) + (size_t)g * 512 * 640;
    for (int e = tid; e < 512 * 320; e += 512) {
        const int n = e / 320, k = (e % 320) * 2, t = n >> 4, co = n & 15; h16x2 v;
        if (k < 512) { const int tau = k >> 4, ci = k & 15;
            if (tau <= t) { v.x = (h16)Kt[(t - tau) * 256 + co * 16 + ci]; v.y = (h16)Kt[(t - tau) * 256 + co * 16 + ci + 1]; } else { v.x = (h16)0.f; v.y = (h16)0.f; } }
        else if (k < 576) { const int p = k - 512;
            v.x = (h16)(ccr[co * 64 + p] * abr[(t + 1) * 64 + p] - cci[co * 64 + p] * abi[(t + 1) * 64 + p]);
            v.y = (h16)(ccr[co * 64 + p + 1] * abr[(t + 1) * 64 + p + 1] - cci[co * 64 + p + 1] * abi[(t + 1) * 64 + p + 1]); }
        else { const int p = k - 576;
            v.x = (h16)(-(ccr[co * 64 + p] * abi[(t + 1) * 64 + p] + cci[co * 64 + p] * abr[(t + 1) * 64 + p]));
            v.y = (h16)(-(ccr[co * 64 + p + 1] * abi[(t + 1) * 64 + p + 1] + cci[co * 64 + p + 1] * abr[(t + 1) * 64 + p + 1])); }
        *(h16x2*)(M2 + (size_t)n * 640 + k) = v;
    }
    if (tid < 64) { f32x2 a; a.x = abr[32 * 64 + tid]; a.y = abi[32 * 64 + tid]; *(f32x2*)(P.ws + OFF_A32 + ((size_t)jg * 64 + tid) * 8) = a; }
    __syncthreads();
}

__device__ __forceinline__ void ln_pass(h16* Y16, const float* g, const float* b) {
    int tid_ = threadIdx.x; asm volatile("" : "+v"(tid_));
    const int lane = tid_ & 63, wave = tid_ >> 6;
    f32x4 gv[4], bv[4];
#pragma unroll
    for (int j = 0; j < 2; ++j)
#pragma unroll
        for (int q = 0; q < 2; ++q) { gv[2 * j + q] = *(const f32x4*)(g + 8 * lane + 512 * j + 4 * q); bv[2 * j + q] = *(const f32x4*)(b + 8 * lane + 512 * j + 4 * q); }
    for (int row0 = (blockIdx.x * 8 + wave) * 4; row0 < NTOK; row0 += gridDim.x * 32) {
        h16x8 w[4][2];
#pragma unroll
        for (int r = 0; r < 4; ++r)
#pragma unroll
            for (int j = 0; j < 2; ++j) w[r][j] = *(const h16x8*)(Y16 + (size_t)(row0 + r) * DM + 8 * lane + 512 * j);
#pragma unroll
        for (int r = 0; r < 4; ++r) {
            h16* yr = Y16 + (size_t)(row0 + r) * DM + 8 * lane; f32x4 v[4]; float s = 0.f;
#pragma unroll
            for (int j = 0; j < 2; ++j) {
                v[2 * j] = (f32x4){(float)w[r][j][0], (float)w[r][j][1], (float)w[r][j][2], (float)w[r][j][3]}; v[2 * j + 1] = (f32x4){(float)w[r][j][4], (float)w[r][j][5], (float)w[r][j][6], (float)w[r][j][7]}; }
#pragma unroll
            for (int j = 0; j < 4; ++j) s += (v[j].x + v[j].y) + (v[j].z + v[j].w);
            const float mean = wave_sum(s) * (1.f / DM); float s2 = 0.f;
#pragma unroll
            for (int j = 0; j < 4; ++j) { v[j] = v[j] - mean; s2 += (v[j].x * v[j].x + v[j].y * v[j].y) + (v[j].z * v[j].z + v[j].w * v[j].w); }
            const float rstd = 1.f / sqrtf(wave_sum(s2) * (1.f / DM) + LN_EPS);
#pragma unroll
            for (int j = 0; j < 2; ++j) { const f32x4 o0 = v[2 * j] * rstd * gv[2 * j] + bv[2 * j], o1 = v[2 * j + 1] * rstd * gv[2 * j + 1] + bv[2 * j + 1]; h16x8 o;
                o[0] = (h16)o0.x; o[1] = (h16)o0.y; o[2] = (h16)o0.z; o[3] = (h16)o0.w; o[4] = (h16)o1.x; o[5] = (h16)o1.y; o[6] = (h16)o1.z; o[7] = (h16)o1.w;
                *(h16x8*)(yr + 512 * j) = o; }
        }
    }
}

__device__ __forceinline__ void cvt_pass(const float* src, h16* dst, size_t n, float* dup) {
    for (size_t i = ((size_t)blockIdx.x * 512 + threadIdx.x) * 8; i < n; i += (size_t)gridDim.x * 512 * 8) {
        const f32x4 a = *(const f32x4*)(src + i), b = *(const f32x4*)(src + i + 4);
        h16x8 o; o[0] = (h16)a.x; o[1] = (h16)a.y; o[2] = (h16)a.z; o[3] = (h16)a.w; o[4] = (h16)b.x; o[5] = (h16)b.y; o[6] = (h16)b.z; o[7] = (h16)b.w;
        *(h16x8*)(dst + i) = o;
        if (dup) { *(f32x4*)(dup + i) = a; *(f32x4*)(dup + i + 4) = b; }
    }
}

__device__ __forceinline__ void conv_pass(const h16* PE, const float* cw, h16* MIXA) {
    for (size_t i = (size_t)blockIdx.x * 512 + threadIdx.x; i < (size_t)NTOK * 64; i += (size_t)gridDim.x * 512) {
        const int row = (int)(i >> 6), c = (int)(i & 63) * 8, l = row & (SEQ - 1);
        const h16* pr = PE + (size_t)row * 1536 + c;
        const h16x8 h0 = *(const h16x8*)pr, gb = *(const h16x8*)(pr + 512), g0 = *(const h16x8*)(pr + 1024);
        h16x8 h1, g1, h2, g2;
        if (l >= 1) { h1 = *(const h16x8*)(pr - 1536); g1 = *(const h16x8*)(pr - 1536 + 1024); }
        if (l >= 2) { h2 = *(const h16x8*)(pr - 3072); g2 = *(const h16x8*)(pr - 3072 + 1024); }
        h16x8 o;
#pragma unroll
        for (int e = 0; e < 8; ++e) {
            float v = cw[1024 + c + e] * ((float)g0[e] * (float)h0[e]);
            if (l >= 1) v += cw[512 + c + e] * ((float)g1[e] * (float)h1[e]);
            if (l >= 2) v += cw[c + e] * ((float)g2[e] * (float)h2[e]);
            o[e] = (h16)((float)gb[e] * v);
        }
        *(h16x8*)(MIXA + (size_t)row * DM + c) = o;
    }
}
__device__ __forceinline__ void carry_unit(const float* SLOC, h16* UG, const float* A32, unsigned char* shm, int b, int g) {
    int tid_ = threadIdx.x; asm volatile("" : "+v"(tid_));
    const int p = tid_ & 63, seg = tid_ >> 6;
    f32x2* segE = (f32x2*)shm;
    f32x2* segS = (f32x2*)(shm + 4096);
    const f32x2 a = *(const f32x2*)(A32 + ((size_t)g * 64 + p) * 2);
    const size_t row0 = (size_t)g * 1024 + b * 256 + seg * 32;
    float sr = 0.f, si = 0.f;
    for (int k0 = 0; k0 < 32; k0 += 4) {
        float xr[4], xi[4];
#pragma unroll
        for (int k = 0; k < 4; ++k) { xr[k] = SLOC[(row0 + k0 + k) * 128 + p]; xi[k] = SLOC[(row0 + k0 + k) * 128 + 64 + p]; }
#pragma unroll
        for (int k = 0; k < 4; ++k) { const float t = a.x * sr - a.y * si + xr[k]; si = a.x * si + a.y * sr + xi[k]; sr = t; }
    }
    { f32x2 e; e.x = sr; e.y = si; segE[seg * 64 + p] = e; }
    __syncthreads();
    if (seg == 0) {
        float mr = a.x, mi = a.y;
#pragma unroll
        for (int q = 0; q < 5; ++q) { const float t = mr * mr - mi * mi; mi = 2.f * mr * mi; mr = t; }
        float cr = 0.f, ci = 0.f;
#pragma unroll
        for (int s = 0; s < 8; ++s) { f32x2 st; st.x = cr; st.y = ci; segS[s * 64 + p] = st; const f32x2 e = segE[s * 64 + p];
            const float t = mr * cr - mi * ci + e.x; ci = mr * ci + mi * cr + e.y; cr = t; }
    }
    __syncthreads();
    { const f32x2 st = segS[seg * 64 + p]; sr = st.x; si = st.y; }
    for (int k0 = 0; k0 < 32; k0 += 4) {
        float xr[4], xi[4];
#pragma unroll
        for (int k = 0; k < 4; ++k) { xr[k] = SLOC[(row0 + k0 + k) * 128 + p]; xi[k] = SLOC[(row0 + k0 + k) * 128 + 64 + p]; }
#pragma unroll
        for (int k = 0; k < 4; ++k) {
            h16* ur = UG + (row0 + k0 + k) * 640 + 512 + p; ur[0] = (h16)(sr * 1024.f); ur[64] = (h16)(si * 1024.f);
            const float t = a.x * sr - a.y * si + xr[k]; si = a.x * si + a.y * sr + xi[k]; sr = t;
        }
    }
    __syncthreads();
}

#define XB_TMO      128
#define XB_XCNT(j)  (256  + 64 * (j))
#define XB_XSUB(j)  (1280 + 64 * (j))
#define XB_XGEN(j)  (2304 + 64 * (j))
#define XB_TOP      3328
#define XB_TOPGEN   3392
#define XCD_BAR_WORDS 3456
#define XB_SPIN_CAP (1u << 22)
__device__ __forceinline__ unsigned xb_ld(unsigned* p)              { return __hip_atomic_load(p, __ATOMIC_RELAXED, __HIP_MEMORY_SCOPE_AGENT); }
__device__ __forceinline__ unsigned xb_add(unsigned* p, unsigned v) { return __hip_atomic_fetch_add(p, v, __ATOMIC_RELAXED, __HIP_MEMORY_SCOPE_AGENT); }
__device__ __forceinline__ unsigned xb_xcc_id() { return (unsigned)__builtin_amdgcn_s_getreg((3 << 11) | 20) & 0xFu; }
#define XB_SPIN(cond, bar) do { unsigned _sp = 0; while (cond) { __builtin_amdgcn_s_sleep(1); \
    if ((++_sp & 255u) == 0u) { if (xb_ld(&(bar)[XB_TMO])) break; if (_sp > XB_SPIN_CAP) { atomicAdd(&(bar)[XB_TMO], 1u); break; } } } } while (0)
__device__ __forceinline__ void xcd_barrier_complete(unsigned* bar, unsigned x, unsigned& nloc, unsigned& nx) {
    const unsigned G = gridDim.x;
    unsigned sum, cnt, mine, sp = 0u;
    for (;;) {
        sum = 0u; cnt = 0u; mine = 0u;
#pragma unroll
        for (unsigned j = 0; j < 16; ++j) { const unsigned c = xb_ld(&bar[XB_XCNT(j)]); sum += c; cnt += (c > 0u) ? 1u : 0u; mine = (j == x) ? c : mine; }
        if (sum == G) break;
        __builtin_amdgcn_s_sleep(1);
        if ((++sp & 255u) == 0u) { if (xb_ld(&bar[XB_TMO])) break; if (sp > XB_SPIN_CAP) { atomicAdd(&bar[XB_TMO], 1u); break; } }
    }
    nloc = mine > 0u ? mine : 1u; nx = cnt > 0u ? cnt : 1u;
}
__device__ __forceinline__ void xcd_barrier(unsigned* bar, volatile LAS unsigned* st) {
    asm volatile("s_waitcnt vmcnt(0)" ::: "memory");
    __syncthreads();
    if (threadIdx.x == 0) {
        const unsigned x = xb_xcc_id();
        __builtin_amdgcn_s_waitcnt(0);
        unsigned nloc = st[0], nx = st[1];
        if (nloc == 0u) { xcd_barrier_complete(bar, x, nloc, nx); st[0] = nloc; st[1] = nx; }
        const unsigned old = xb_add(&bar[XB_XSUB(x)], 1u);
        const unsigned gen = old / nloc;
        if (old + 1u == (gen + 1u) * nloc) {
            __builtin_amdgcn_fence(__ATOMIC_RELEASE, "agent");
            asm volatile("s_waitcnt vmcnt(0)" ::: "memory");
            const unsigned og = xb_add(&bar[XB_TOP], 1u);
            const unsigned tg = og / nx;
            if (og + 1u == (tg + 1u) * nx) xb_add(&bar[XB_TOPGEN], 1u);
            else XB_SPIN(xb_ld(&bar[XB_TOPGEN]) == tg, bar);
            __builtin_amdgcn_fence(__ATOMIC_ACQUIRE, "agent");
            xb_add(&bar[XB_XGEN(x)], 1u);
            asm volatile("s_waitcnt vmcnt(0)" ::: "memory");
        } else {
            XB_SPIN(xb_ld(&bar[XB_XGEN(x)]) == gen, bar);
            __builtin_amdgcn_fence(__ATOMIC_ACQUIRE, "agent");
            asm volatile("s_waitcnt vmcnt(0)" ::: "memory");
        }
    }
    __syncthreads();
}

__device__ __forceinline__ bool xcd_unit_rank(unsigned* bar, unsigned x, unsigned r, int U, int u, int& rank, int& total) {
    unsigned c[16];
#pragma unroll
    for (int j = 0; j < 16; ++j) c[j] = xb_ld(&bar[XB_XCNT(j)]);
    int nx = 0, myo = 0;
#pragma unroll
    for (int j = 0; j < 16; ++j) if (c[j]) { if ((unsigned)j < x) ++myo; ++nx; }
    const int m = nx < U ? nx : U, um = u % m;
    if (myo % m != um) return false;
    int ord = 0; rank = (int)r; total = 0;
#pragma unroll
    for (int j = 0; j < 16; ++j) if (c[j]) { if (ord % m == um) { total += (int)c[j]; if ((unsigned)j < x) rank += (int)c[j]; } ++ord; }
    return true;
}

template <int PASS>
__device__ __forceinline__ void idx_tiles(const unsigned char* buf, int Tbase, int tq, int fr, int fq, const h16x8 (&aq)[2][2], const float (&wv)[8], const h16x2 (&wp)[4],
                                          unsigned* myhist, unsigned b0, unsigned* myctl, unsigned* mycand, unsigned short* out) {
    const int sw = (fr >> 1) & 7;
    const unsigned char* lp = buf + fr * 128;
#pragma unroll
    for (int hb = 0; hb < 2; ++hb) {
        h16x8 kf[8][2];
#pragma unroll
        for (int e = 0; e < 8; ++e) { const unsigned char* tp = lp + (hb * 8 + e) * 2048; kf[e][0] = *(const h16x8*)(tp + ((fq ^ sw) << 4)); kf[e][1] = *(const h16x8*)(tp + (((fq + 4) ^ sw) << 4)); }
#pragma unroll
        for (int e = 0; e < 8; ++e) { const int T = Tbase + hb * 8 + e;
            f32x4 a0 = (f32x4){0.f, 0.f, 0.f, 0.f}, a1 = a0;
            a0 = __builtin_amdgcn_mfma_f32_16x16x32_f16(aq[0][0], kf[e][0], a0, 0, 0, 0); a0 = __builtin_amdgcn_mfma_f32_16x16x32_f16(aq[0][1], kf[e][1], a0, 0, 0, 0);
            a1 = __builtin_amdgcn_mfma_f32_16x16x32_f16(aq[1][0], kf[e][0], a1, 0, 0, 0); a1 = __builtin_amdgcn_mfma_f32_16x16x32_f16(aq[1][1], kf[e][1], a1, 0, 0, 0);
            const h16x2 z2 = (h16x2){(h16)0.f, (h16)0.f};
            const h16x2 r0 = __builtin_elementwise_max(__builtin_bit_cast(h16x2, __builtin_amdgcn_cvt_pkrtz(a0[0], a0[1])), z2), r1 = __builtin_elementwise_max(__builtin_bit_cast(h16x2, __builtin_amdgcn_cvt_pkrtz(a0[2], a0[3])), z2);
            const h16x2 r2 = __builtin_elementwise_max(__builtin_bit_cast(h16x2, __builtin_amdgcn_cvt_pkrtz(a1[0], a1[1])), z2), r3 = __builtin_elementwise_max(__builtin_bit_cast(h16x2, __builtin_amdgcn_cvt_pkrtz(a1[2], a1[3])), z2);
            const float sa = __builtin_amdgcn_fdot2(r0, wp[0], __builtin_amdgcn_fdot2(r1, wp[1], __builtin_amdgcn_fdot2(r2, wp[2], __builtin_amdgcn_fdot2(r3, wp[3], 0.f, false), false), false), false);
            const int key = 16 * T + fr;
            if (key <= tq) {
                const unsigned bin = (unsigned)(int)fminf(fmaxf(sa * 32.f + 128.f, 0.f), 255.f);
                if (PASS == 1) { if (bin >= b0) atomicAdd(&myhist[fq * 256 + bin], 1u); }
                else {
                    if (bin > b0) { const unsigned pos = atomicAdd(&myctl[fq * 4 + 2], 1u); ((unsigned short*)myhist)[fq * 256 + (pos & 255u)] = (unsigned short)key; }
                    else if (bin == b0) { const unsigned c = atomicAdd(&myctl[fq * 4 + 3], 1u);
                        if (c < 128u) { float s = 0.f;
#pragma unroll
                            for (int r = 0; r < 4; ++r) s += wv[r] * fmaxf(a0[r], 0.f) + wv[4 + r] * fmaxf(a1[r], 0.f);
                            s = fminf(fmaxf(s, -3.99f), 3.99f);
                            mycand[(fq * 128 + c) * 2] = (unsigned)((s + 4.f) * 536870912.f); mycand[(fq * 128 + c) * 2 + 1] = (unsigned)key; } }
                }
            }
        }
        __builtin_amdgcn_sched_barrier(0);
    }
}
template <int PASS, bool SAMPLE>
__device__ __forceinline__ void idx_sweep(const h16* KIb, int nch, unsigned char* stage, int tid, int tq, int fr, int fq, const h16x8 (&aq)[2][2], const float (&wv)[8], const h16x2 (&wp)[4],
                                          unsigned* myhist, unsigned b0, unsigned* myctl, unsigned* mycand, unsigned short* out) {
    int loff[4];
#pragma unroll
    for (int i = 0; i < 4; ++i) { const int o = (tid + 512 * i) * 16, R = o >> 7, c16 = (o >> 4) & 7, r = R & 15; loff[i] = (R >> 4) * 2048 + r * 128 + ((c16 ^ ((r >> 1) & 7)) << 4); }
    const unsigned char* src = (const unsigned char*)KIb + tid * 16;
    h16x8 st[4];
    const int rot = (int)((blockIdx.x * 7u) % (unsigned)nch);
#pragma unroll
    for (int i = 0; i < 4; ++i) st[i] = *(const h16x8*)(src + (size_t)rot * 32768 + 8192 * i);
#pragma unroll
    for (int i = 0; i < 4; ++i) *(h16x8*)(stage + loff[i]) = st[i];
    __syncthreads();
    for (int c = 0; c < nch; ++c) {
        const bool more = (c + 1) < nch;
        int cc = c + rot; cc = cc >= nch ? cc - nch : cc;
        int cn = cc + 1; cn = cn >= nch ? 0 : cn;
        if (more) {
#pragma unroll
            for (int i = 0; i < 4; ++i) st[i] = *(const h16x8*)(src + (size_t)cn * 32768 + 8192 * i); }
        idx_tiles<PASS>(stage + (c & 1) * 32768, cc * 16, tq, fr, fq, aq, wv, wp, myhist, b0, myctl, mycand, out);
        if (PASS == 1 && SAMPLE && c == 1 && nch > 2) {
            asm volatile("s_waitcnt lgkmcnt(0)" ::: "memory");
            const unsigned want = (unsigned)((tq + 1) < 256 ? (tq + 1) : 256);
            unsigned cnt[16]; unsigned lsum = 0u;
#pragma unroll
            for (int i = 0; i < 16; ++i) { cnt[i] = myhist[fq * 256 + fr * 16 + i]; lsum += cnt[i]; }
            unsigned incl = lsum;
#pragma unroll
            for (int o = 1; o < 16; o <<= 1) { const unsigned v = __shfl_down(incl, o); if (fr + o < 16) incl += v; }
            const unsigned ns = __shfl(incl, fq * 16);
            const unsigned target = (unsigned)(2.f * (float)want * (float)ns / (float)(tq + 1)) + 10u;
            const unsigned above = incl - lsum;
            if (fr == 0) myctl[fq * 4] = 0u;
            asm volatile("s_waitcnt lgkmcnt(0)" ::: "memory");
            if (target < ns && above < target && target <= incl) { unsigned cum = above; int bin = 0; bool found = false;
#pragma unroll
                for (int i = 15; i >= 0; --i) { if (!found) { if (cum + cnt[i] >= target) { bin = i; found = true; } else cum += cnt[i]; } }
                myctl[fq * 4] = (unsigned)(fr * 16 + bin); }
            asm volatile("s_waitcnt lgkmcnt(0)" ::: "memory");
            const unsigned fb = myctl[fq * 4];
            b0 = fb > 0u ? fb - 1u : 0u;
            if (fr == 0) myctl[fq * 4 + 1] = b0;
        }
        if (more) {
#pragma unroll
            for (int i = 0; i < 4; ++i) *(h16x8*)(stage + ((c + 1) & 1) * 32768 + loff[i]) = st[i]; }
        __syncthreads();
    }
}

__device__ __forceinline__ void dsa_select(const h16* PROJ, unsigned short* IDX, int* CNT, unsigned char* shm, unsigned* bar, unsigned xcc, unsigned xrank) {
    int tid_ = threadIdx.x; asm volatile("" : "+v"(tid_));
    const int tid = tid_, wid = tid >> 6, lane = tid & 63, fr = lane & 15, fq = lane >> 4;
    unsigned char* stage = shm;
    unsigned* myhist = (unsigned*)(shm + 65536) + wid * 1024;
    unsigned* mycand = (unsigned*)(shm + 98304) + wid * 1024;
    unsigned* myctl = (unsigned*)(shm + 131072) + wid * 16;
    for (int b = 0; b < NBATCH; ++b) {
        int rank, total; if (!xcd_unit_rank(bar, xcc, xrank, NBATCH, b, rank, total)) continue;
        const int nrounds = (256 + total - 1) / total;
        const h16* KIb = PROJ + O_KI + (size_t)b * SEQ * 64;
        for (int k = 0; k < nrounds; ++k) {
            const int it = k * total + ((k & 1) ? (total - 1 - rank) : rank);
            if (it >= 256) continue;
            const int tokbase = b * SEQ, t0 = it * 32 + wid * 4, tq = t0 + fq;
            const int nch = ((it * 32 + 31) / 16 + 1 + 15) / 16;
#pragma unroll
            for (int i = 0; i < 16; ++i) myhist[lane + 64 * i] = 0u;
            if (lane < 16) myctl[lane] = 0u;
            h16x8 aq[2][2];
            { const h16* qrow = PROJ + O_QI + (size_t)(tokbase + t0 + (fr >> 2)) * 512 + (fr & 3) * 64 + 8 * fq;
#pragma unroll
              for (int hh = 0; hh < 2; ++hh)
#pragma unroll
                  for (int kk = 0; kk < 2; ++kk) aq[hh][kk] = *(const h16x8*)(qrow + hh * 256 + kk * 32); }
            float wv[8];
            { const h16x8 w8 = *(const h16x8*)(PROJ + O_WI + (size_t)(tokbase + tq) * 8);
#pragma unroll
              for (int h = 0; h < 8; ++h) wv[h] = (float)w8[h] * 0.04419417382415922f; }
            h16x2 wp[4];
#pragma unroll
            for (int h = 0; h < 4; ++h) { wp[h].x = (h16)wv[(h >> 1) * 4 + (h & 1) * 2]; wp[h].y = (h16)wv[(h >> 1) * 4 + (h & 1) * 2 + 1]; }
            __builtin_amdgcn_s_waitcnt(0);
            unsigned short* out = IDX + (size_t)(tokbase + tq) * 256;
            unsigned* blkflag = (unsigned*)(shm + 131072 + 1024);
            if (tid == 0) *blkflag = 0u;
            idx_sweep<1, true>(KIb, nch, stage, tid, tq, fr, fq, aq, wv, wp, myhist, 0u, myctl, mycand, out);
            {
                unsigned tot = 0u; const unsigned flo = myctl[fq * 4 + 1];
#pragma unroll
                for (int i = 0; i < 16; ++i) { const unsigned cb = myhist[fq * 256 + fr * 16 + i]; tot += ((unsigned)(fr * 16 + i) >= flo) ? cb : 0u; }
#pragma unroll
                for (int o = 1; o < 16; o <<= 1) tot += __shfl_xor(tot, o);
                const unsigned want0 = (unsigned)((tq + 1) < 256 ? (tq + 1) : 256);
                if (tot < want0) *blkflag = 1u;
                __syncthreads();
                if (*blkflag != 0u) {
#pragma unroll
                    for (int i = 0; i < 16; ++i) myhist[lane + 64 * i] = 0u;
                    asm volatile("s_waitcnt lgkmcnt(0)" ::: "memory");
                    idx_sweep<1, false>(KIb, nch, stage, tid, tq, fr, fq, aq, wv, wp, myhist, 0u, myctl, mycand, out);
                }
            }
            { const unsigned want = (unsigned)((tq + 1) < 256 ? (tq + 1) : 256);
              unsigned c[16]; unsigned lsum = 0u;
#pragma unroll
              for (int i = 0; i < 16; ++i) { c[i] = myhist[fq * 256 + fr * 16 + i]; lsum += c[i]; }
              unsigned incl = lsum;
#pragma unroll
              for (int o = 1; o < 16; o <<= 1) { const unsigned v = __shfl_down(incl, o); if (fr + o < 16) incl += v; }
              const unsigned above = incl - lsum;
              if (above < want && want <= incl) { unsigned cum = above; int bin = 0; bool found = false;
#pragma unroll
                  for (int i = 15; i >= 0; --i) { if (!found) { if (cum + c[i] >= want) { bin = i; found = true; } else cum += c[i]; } }
                  myctl[fq * 4] = (unsigned)(fr * 16 + bin); myctl[fq * 4 + 1] = want - cum; } }
            asm volatile("s_waitcnt lgkmcnt(0)" ::: "memory");
            const unsigned b0 = myctl[fq * 4];
            idx_sweep<2, false>(KIb, nch, stage, tid, tq, fr, fq, aq, wv, wp, myhist, b0, myctl, mycand, out);
            { const unsigned nc = myctl[fq * 4 + 3], need = myctl[fq * 4 + 1]; const int n = (int)(nc < 128u ? nc : 128u);
              for (int ci = fr; ci < n; ci += 16) { const unsigned ki = mycand[(fq * 128 + ci) * 2], ii = mycand[(fq * 128 + ci) * 2 + 1]; unsigned rk = 0u;
                  for (int jx = 0; jx < n; ++jx) { const unsigned kj = mycand[(fq * 128 + jx) * 2], ij = mycand[(fq * 128 + jx) * 2 + 1]; rk += (kj > ki || (kj == ki && ij < ii)) ? 1u : 0u; }
                  if (rk < need) { const unsigned pos = atomicAdd(&myctl[fq * 4 + 2], 1u); ((unsigned short*)myhist)[fq * 256 + (pos & 255u)] = (unsigned short)ii; } } }
            asm volatile("s_waitcnt lgkmcnt(0)" ::: "memory");
            { const uint4* sp = (const uint4*)((const unsigned short*)myhist + fq * 256 + fr * 16); uint4* dp = (uint4*)(out + fr * 16); dp[0] = sp[0]; dp[1] = sp[1]; }
            if (fr == 0) CNT[tokbase + tq] = (int)myctl[fq * 4 + 2];
            __syncthreads();
        }
    }
}

__device__ __forceinline__ void dsa_attend(const h16* PROJ, const unsigned short* IDX, const int* CNT, h16* MIXA, unsigned char* shm, unsigned* bar, unsigned xcc, unsigned xrank) {
    float* Pl = (float*)shm;
    unsigned short* selw = (unsigned short*)(shm + 32768);
    int tid_ = threadIdx.x; asm volatile("" : "+v"(tid_));
    const int tid = tid_, wid = tid >> 6, lane = tid & 63, fr = lane & 15, fq = lane >> 4;
    unsigned short* sel = selw + wid * 256;
    const int qq = 0;
    for (int u = 0; u < 2 * NBATCH; ++u) {
        int rank, total; if (!xcd_unit_rank(bar, xcc, xrank, 2 * NBATCH, u, rank, total)) continue;
        const int b = u >> 1, g = u & 1, tokbase = b * SEQ;
        for (int it = rank; it < 1024; it += total) {
            const int t = it * 8 + wid, tokq = tokbase + t; int nsel = __builtin_amdgcn_readfirstlane(CNT[tokq]); nsel = nsel < 1 ? 1 : (nsel > 256 ? 256 : nsel);
            *(unsigned long long*)(sel + 4 * lane) = *(const unsigned long long*)(IDX + (size_t)tokq * 256 + 4 * lane);
            asm volatile("s_waitcnt vmcnt(0) lgkmcnt(0)" ::: "memory");
            h16x8 qa[4];
#pragma unroll
            for (int kk = 0; kk < 4; ++kk) { h16x8 z;
#pragma unroll
                for (int e = 0; e < 8; ++e) z[e] = (h16)0.f;
                qa[kk] = z; }
            if (fr < 4) { const h16* qrow = PROJ + O_Q + (size_t)tokq * 1024 + (g * 4 + fr) * 128 + 16 * fq;
#pragma unroll
                for (int kk = 0; kk < 4; ++kk) qa[kk] = *(const h16x8*)(qrow + (kk & 1) * 8 + (kk >> 1) * 64); }
            long qa8[4];
#pragma unroll
            for (int kk = 0; kk < 4; ++kk) {
                int w0 = __builtin_amdgcn_cvt_pk_fp8_f32((float)qa[kk][0], (float)qa[kk][1], 0, false); w0 = __builtin_amdgcn_cvt_pk_fp8_f32((float)qa[kk][2], (float)qa[kk][3], w0, true);
                int w1 = __builtin_amdgcn_cvt_pk_fp8_f32((float)qa[kk][4], (float)qa[kk][5], 0, false); w1 = __builtin_amdgcn_cvt_pk_fp8_f32((float)qa[kk][6], (float)qa[kk][7], w1, true);
                qa8[kk] = (long)(((unsigned long long)(unsigned)w1 << 32) | (unsigned long long)(unsigned)w0); }
            f32x4 sacc[16];
            const unsigned char* kbase8 = (const unsigned char*)(PROJ + O_KG) + (size_t)(b * 2 + g) * SEQ * 128 + 16 * fq;
            {
                uint4 kf[16][2];
#pragma unroll
                for (int e = 0; e < 16; ++e) { const int slot = 16 * e + fr; const int idx = (int)sel[qq * 256 + (slot < nsel ? slot : nsel - 1)];
                    const unsigned char* krow = kbase8 + (size_t)idx * 128;
                    kf[e][0] = *(const uint4*)krow; kf[e][1] = *(const uint4*)(krow + 64); }
                __builtin_amdgcn_sched_barrier(0);
#pragma unroll
                for (int e = 0; e < 16; ++e) {
                    f32x4 a = (f32x4){0.f, 0.f, 0.f, 0.f};
#pragma unroll
                    for (int L = 0; L < 2; ++L) {
                        const long k0 = (long)(((unsigned long long)kf[e][L].y << 32) | (unsigned long long)kf[e][L].x), k1 = (long)(((unsigned long long)kf[e][L].w << 32) | (unsigned long long)kf[e][L].z);
                        a = __builtin_amdgcn_mfma_f32_16x16x32_fp8_fp8(qa8[2 * L], k0, a, 0, 0, 0); a = __builtin_amdgcn_mfma_f32_16x16x32_fp8_fp8(qa8[2 * L + 1], k1, a, 0, 0, 0); }
                    if (16 * e + fr >= nsel) a = (f32x4){-1e30f, -1e30f, -1e30f, -1e30f};
                    sacc[e] = a; }
                __builtin_amdgcn_sched_barrier(0);
            }
            f32x4 mx = sacc[0];
#pragma unroll
            for (int jt = 1; jt < 16; ++jt)
#pragma unroll
                for (int i = 0; i < 4; ++i) mx[i] = fmaxf(mx[i], sacc[jt][i]);
#pragma unroll
            for (int o = 1; o < 16; o <<= 1)
#pragma unroll
                for (int i = 0; i < 4; ++i) mx[i] = fmaxf(mx[i], __shfl_xor(mx[i], o));
            f32x4 sm = (f32x4){0.f, 0.f, 0.f, 0.f};
            const float sc = 0.08838834764831845f;
#pragma unroll
            for (int jt = 0; jt < 16; ++jt)
#pragma unroll
                for (int i = 0; i < 4; ++i) { const float e = __expf((sacc[jt][i] - mx[i]) * sc); sacc[jt][i] = e; sm[i] += e; }
#pragma unroll
            for (int o = 1; o < 16; o <<= 1)
#pragma unroll
                for (int i = 0; i < 4; ++i) sm[i] += __shfl_xor(sm[i], o);
            f32x4 inv;
#pragma unroll
            for (int i = 0; i < 4; ++i) inv[i] = 1.f / sm[i];
            if (fq == 0) {
#pragma unroll
                for (int jt = 0; jt < 16; ++jt) *(f32x4*)(Pl + ((size_t)wid * 256 + 16 * jt + fr) * 4) = sacc[jt] * inv;
            }
            asm volatile("s_waitcnt lgkmcnt(0)" ::: "memory");
            const int r8 = lane >> 3, c8 = lane & 7;
            const unsigned char* vbase8 = (const unsigned char*)(PROJ + O_VG) + (size_t)(b * 2 + g) * SEQ * 128 + 16 * c8;
            f32x2 oa2[4][8];
#pragma unroll
            for (int h = 0; h < 4; ++h)
#pragma unroll
                for (int d = 0; d < 8; ++d) oa2[h][d] = (f32x2){0.f, 0.f};
            for (int s0 = 0; s0 < nsel; s0 += 128) {
                uint4 vv[16];
#pragma unroll
                for (int e = 0; e < 16; ++e) { const int slot = s0 + 8 * e + r8; const int idx = (int)sel[qq * 256 + (slot < nsel ? slot : nsel - 1)];
                    vv[e] = *(const uint4*)(vbase8 + (size_t)idx * 128); }
                __builtin_amdgcn_sched_barrier(0);
#pragma unroll
                for (int e = 0; e < 16; ++e) { const int slot = s0 + 8 * e + r8;
                    if ((e & 3) == 0) __builtin_amdgcn_sched_barrier(0);
                    const f32x4 pp = *(const f32x4*)(Pl + ((size_t)wid * 256 + slot) * 4);
                    const f32x2 p0 = (f32x2){pp.x, pp.x}, p1 = (f32x2){pp.y, pp.y}, p2 = (f32x2){pp.z, pp.z}, p3 = (f32x2){pp.w, pp.w};
                    const unsigned wds[4] = {vv[e].x, vv[e].y, vv[e].z, vv[e].w};
#pragma unroll
                    for (int w = 0; w < 4; ++w) {
                        const f32x2 lo = __builtin_amdgcn_cvt_pk_f32_fp8((int)wds[w], false), hi = __builtin_amdgcn_cvt_pk_f32_fp8((int)wds[w], true);
                        oa2[0][2 * w] = __builtin_elementwise_fma(lo, p0, oa2[0][2 * w]); oa2[0][2 * w + 1] = __builtin_elementwise_fma(hi, p0, oa2[0][2 * w + 1]);
                        oa2[1][2 * w] = __builtin_elementwise_fma(lo, p1, oa2[1][2 * w]); oa2[1][2 * w + 1] = __builtin_elementwise_fma(hi, p1, oa2[1][2 * w + 1]);
                        oa2[2][2 * w] = __builtin_elementwise_fma(lo, p2, oa2[2][2 * w]); oa2[2][2 * w + 1] = __builtin_elementwise_fma(hi, p2, oa2[2][2 * w + 1]);
                        oa2[3][2 * w] = __builtin_elementwise_fma(lo, p3, oa2[3][2 * w]); oa2[3][2 * w + 1] = __builtin_elementwise_fma(hi, p3, oa2[3][2 * w + 1]); }
                }
            }
#pragma unroll
            for (int h = 0; h < 4; ++h)
#pragma unroll
                for (int d = 0; d < 8; ++d) { f32x2 v = oa2[h][d];
                    v.x += __shfl_xor(v.x, 8); v.y += __shfl_xor(v.y, 8); v.x += __shfl_xor(v.x, 16); v.y += __shfl_xor(v.y, 16); v.x += __shfl_xor(v.x, 32); v.y += __shfl_xor(v.y, 32); oa2[h][d] = v; }
            if (r8 == 0) {
                h16* orow = MIXA + (size_t)tokq * DM + (g * 4) * 128 + 16 * c8;
#pragma unroll
                for (int h = 0; h < 4; ++h) { h16x8 w0, w1;
#pragma unroll
                    for (int d = 0; d < 4; ++d) { w0[2 * d] = (h16)oa2[h][d].x; w0[2 * d + 1] = (h16)oa2[h][d].y; w1[2 * d] = (h16)oa2[h][4 + d].x; w1[2 * d + 1] = (h16)oa2[h][4 + d].y; }
                    *(h16x8*)(orow + h * 128) = w0; *(h16x8*)(orow + h * 128 + 8) = w1; }
            }
            asm volatile("s_waitcnt lgkmcnt(0)" ::: "memory");
        }
    }
}

__device__ __forceinline__ Gemm mk_gemm(const h16* A, int lda, const h16* Bt, int ldb, int M, int N, int K, int nB = 1, size_t sA = 0, size_t sB = 0) {
    Gemm g; g.A = A; g.Bt = Bt; g.lda = lda; g.ldb = ldb; g.nM = M / 256; g.nN = N / 256; g.nB = nB; g.K = K; g.strideA = sA; g.strideB = sB; return g;
}

__device__ __forceinline__ int opaque(int v) { asm volatile("" : "+v"(v)); return v; }
enum { K_FUP0 = 0, K_FDN0, K_LN0, K_MIE, K_S5A, K_CARRY, K_S5B, K_GLU, K_MO, K_LN1, K_FUP1, K_FDN1, K_LN2, K_PLE, K_MIO, K_DSA };
constexpr unsigned long long tbl_even() { const int k[13] = {K_FUP0, K_FDN0, K_LN0, K_MIE, K_S5A, K_S5B, K_GLU, K_MO, K_LN1, K_FUP1, K_FDN1, K_LN2, K_PLE}; unsigned long long r = 0; for (int i = 0; i < 13; ++i) r |= (unsigned long long)k[i] << (4 * i); return r; }
constexpr unsigned long long tbl_odd() { const int k[12] = {K_FUP0, K_FDN0, K_LN0, K_MIO, K_DSA, K_CARRY  , K_MO, K_LN1, K_FUP1, K_FDN1, K_LN2, K_PLE}; unsigned long long r = 0; for (int i = 0; i < 12; ++i) r |= (unsigned long long)k[i] << (4 * i); return r; }

__global__ void __launch_bounds__(512, 2) fwd_megakernel(Params P) {
    extern __shared__ __attribute__((aligned(16))) unsigned char shm[];
    cg::grid_group grid = cg::this_grid();
    LAS unsigned char* lds = (LAS unsigned char*)shm;
    volatile LAS unsigned* xbst = (volatile LAS unsigned*)(lds + LDS_BYTES - 16);
    if (threadIdx.x == 0) { const unsigned x_ = xb_xcc_id(); xbst[0] = 0u; xbst[1] = 0u; xbst[2] = xb_add(&((unsigned*)(P.ws + OFF_BAR))[XB_XCNT(x_)], 1u); xbst[3] = x_; }
    __syncthreads();

    if (blockIdx.x < 64) s5_build(P, blockIdx.x >> 5, blockIdx.x & 31, (float*)shm);
    prep_transposes(P, (float*)shm);
    cvt_pass(P.x, (h16*)(P.ws + OFF_MIXA), (size_t)NTOK * DM, nullptr);
    grid.sync();

    for (int i = 0; i < DEPTH; ++i) {
        const bool even = (i & 1) == 0; const int nst = even ? 13 : 12; const unsigned long long tbl = even ? tbl_even() : tbl_odd();
        for (int st = 0; st < nst; ++st) {
            const int kind = (int)((tbl >> (4 * st)) & 15ull), j = i >> 1;
            unsigned long long ka_ = (unsigned long long)__builtin_amdgcn_kernarg_segment_ptr(); asm volatile("" : "+s"(ka_));
            const __attribute__((address_space(4))) Params* PK = (const __attribute__((address_space(4))) Params*)ka_;
            unsigned char* ws = PK->ws;
            float* H = PK->out;
            h16* H16 = (h16*)(ws + OFF_H16);
            h16* MIXA = (h16*)(ws + OFF_MIXA);
            h16* R1 = (h16*)(ws + OFF_R1);
            h16* UG = (h16*)(ws + OFF_R1 + R1_UG);
            float* SLOC = (float*)(ws + OFF_R1 + R1_SLOC);
            h16* Z = (h16*)(ws + OFF_R1 + R1_Z);
            h16* P16 = (h16*)(ws + OFF_P16);
            EpiArgs E{};
            switch (kind) {
            case K_FUP0: case K_FUP1: {
                const int li = i * 2 + (kind == K_FUP1 ? 1 : 0);
                E.h0 = R1;
                gemm_phase<E_SWIGLU>(lds, mk_gemm(kind == K_FUP0 ? MIXA : H16, DM, (const h16*)(ws + OFF_W13 + li * SZ_W13), DM, NTOK, 5632, DM), E);
            } break;
            case K_FDN0: case K_FDN1: case K_MO: {
                E.ch0 = (kind == K_FDN0) ? MIXA : H16; E.h0 = H16;
                if (kind == K_MO) { E.s0 = 1.f;
                    gemm_phase<E_RES>(lds, mk_gemm(MIXA, DM, (const h16*)(ws + (even ? OFF_ABOUT : OFF_COUT) + j * SZ_SQ), DM, NTOK, DM, DM), E);
                } else { const int li = i * 2 + (kind == K_FDN1 ? 1 : 0); E.s0 = 0.5f;
                    gemm_phase<E_RES>(lds, mk_gemm(R1, DFF, (const h16*)(ws + OFF_W2T + li * SZ_W2T), DFF, NTOK, DM, DFF), E); }
            } break;
            case K_LN0: case K_LN1: case K_LN2: {
                const int idx = i * 3 + (kind == K_LN0 ? 0 : (kind == K_LN1 ? 1 : 2));
                ln_pass(H16, PK->ln_g + (size_t)idx * DM, PK->ln_b + (size_t)idx * DM);
                if (kind == K_LN1) cvt_pass(PK->p + (size_t)i * NTOK * 256, P16, (size_t)NTOK * 256, nullptr);
                if (kind == K_LN2) { E.h0 = R1;
                    gemm_phase<E_PP>(lds, mk_gemm(P16, 256, (const h16*)(ws + OFF_WPT + i * SZ_WPT), 256, NTOK, DM, 256), E); }
            } break;
            case K_MIE: {
                E.h0 = R1; E.h1 = UG;
                gemm_phase<E_PROJ_EVEN>(lds, mk_gemm(H16, DM, (const h16*)(ws + OFF_ABIN + j * SZ_ABIN), DM, NTOK, 2048, DM), E);
            } break;
            case K_S5A: {
                E.f0 = SLOC;
                gemm_phase<E_S5A>(lds, mk_gemm(UG, 640, (const h16*)(ws + OFF_W1M + j * SZ_W1M), 512, 1024, 256, 512, 32, (size_t)1024 * 640, (size_t)256 * 512), E);
                for (int L = blockIdx.x; L < NBATCH * 32; L += gridDim.x) { __syncthreads(); carry_unit(SLOC, UG, (const float*)(ws + OFF_A32) + (size_t)j * 32 * 64 * 2, shm, L & 3, L >> 2); }
                conv_pass(R1, PK->convw + (size_t)j * 1536, MIXA);
            } break;
            case K_CARRY:
                dsa_attend(R1, (const unsigned short*)(ws + OFF_R1 + R1_IDX), (const int*)(ws + OFF_R1 + R1_CNT), MIXA, shm, (unsigned*)(ws + OFF_BAR), xbst[3], xbst[2]);
                break;
            case K_S5B: {
                E.ch0 = UG; E.cf0 = PK->s5d + (size_t)j * 512; E.h0 = Z;
                gemm_phase<E_S5B>(lds, mk_gemm(UG, 640, (const h16*)(ws + OFF_M2 + j * SZ_M2), 640, 1024, 512, 640, 32, (size_t)1024 * 640, (size_t)512 * 640), E);
            } break;
            case K_GLU: {
                E.ch0 = Z; E.cf0 = PK->bglu + (size_t)j * 512; E.h0 = MIXA;
                gemm_phase<E_GLU>(lds, mk_gemm(Z, 512, (const h16*)(ws + OFF_WGLU + j * SZ_WGLU), 512, NTOK, 512, 512), E);
            } break;
            case K_MIO: {
                E.h0 = R1; E.pos = PK->pos;
                gemm_phase<E_PROJ_ODD>(lds, mk_gemm(H16, DM, (const h16*)(ws + OFF_CIN + j * SZ_CIN), DM, NTOK, 2304, DM), E);
            } break;
            case K_DSA: dsa_select(R1, (unsigned short*)(ws + OFF_R1 + R1_IDX), (int*)(ws + OFF_R1 + R1_CNT), shm, (unsigned*)(ws + OFF_BAR), xbst[3], xbst[2]); break;
            case K_PLE: {
                E.f0 = (i == DEPTH - 1) ? H : nullptr; E.ch0 = R1; E.ch1 = H16; E.h0 = MIXA;
                gemm_phase<E_PLE>(lds, mk_gemm(H16, DM, (const h16*)(ws + OFF_WGT + i * SZ_SQ), DM, NTOK, DM, DM), E);
            } break;
            }
            xcd_barrier((unsigned*)(ws + OFF_BAR), xbst);
        }
    }
}

extern "C" void kernel_launch(void* const* d_in, const int* in_sizes, int n_in, void* d_out, int out_size, void* d_ws, size_t ws_size, hipStream_t stream) {
    static int grid_blocks = 0;
    if (grid_blocks == 0) {
        if (n_in != 25 || out_size != NTOK * DM || ws_size < WS_END) { fprintf(stderr, "kernel_launch: unexpected shapes (n_in %d, out %d, ws %zu, need %zu)\n", n_in, out_size, ws_size, (size_t)WS_END); grid_blocks = -1; return; }
        int dev = 0, cus = 0, per_cu = 0;
        hipGetDevice(&dev);
        hipDeviceGetAttribute(&cus, hipDeviceAttributeMultiprocessorCount, dev);
        if (hipFuncSetAttribute((const void*)fwd_megakernel, hipFuncAttributeMaxDynamicSharedMemorySize, LDS_BYTES) != hipSuccess) { fprintf(stderr, "kernel_launch: hipFuncSetAttribute failed\n"); grid_blocks = -1; return; }
        if (hipOccupancyMaxActiveBlocksPerMultiprocessor(&per_cu, (const void*)fwd_megakernel, 512, LDS_BYTES) != hipSuccess || per_cu < 1) { fprintf(stderr, "kernel_launch: occupancy query says %d\n", per_cu); per_cu = 1; }
        (void)hipGetLastError();
        grid_blocks = cus * per_cu;
    }
    if (grid_blocks < 0) return;
    Params p{};
    p.x = (const float*)d_in[0]; p.p = (const float*)d_in[1]; p.pos = (const int*)d_in[2];
    p.ln_g = (const float*)d_in[3]; p.ln_b = (const float*)d_in[4]; p.w1 = (const float*)d_in[5]; p.w3 = (const float*)d_in[6]; p.w2 = (const float*)d_in[7];
    p.plep = (const float*)d_in[8]; p.pleg = (const float*)d_in[9]; p.abin = (const float*)d_in[10]; p.about = (const float*)d_in[11]; p.convw = (const float*)d_in[12];
    p.lamre = (const float*)d_in[13]; p.lamim = (const float*)d_in[14]; p.logdt = (const float*)d_in[15]; p.bre = (const float*)d_in[16]; p.bim = (const float*)d_in[17];
    p.cre = (const float*)d_in[18]; p.cim = (const float*)d_in[19]; p.s5d = (const float*)d_in[20]; p.wglu = (const float*)d_in[21]; p.bglu = (const float*)d_in[22];
    p.cin = (const float*)d_in[23]; p.cout = (const float*)d_in[24];
    p.out = (float*)d_out; p.ws = (unsigned char*)d_ws;
    if (hipMemsetAsync((char*)d_ws + OFF_BAR, 0, 16384, stream) != hipSuccess) { fprintf(stderr, "kernel_launch: memset of barrier words failed\n"); return; }
    void* args[] = {&p};
    hipError_t e = hipLaunchCooperativeKernel((const void*)fwd_megakernel, dim3(grid_blocks), dim3(512), args, LDS_BYTES, stream);
    if (e != hipSuccess) fprintf(stderr, "cooperative launch failed: %s (grid %d)\n", hipGetErrorString(e), grid_blocks);
}
```
